# Optimizing an MI355X kernel written in HIP

```python
import math
import jax, jax.numpy as jnp
from jax import lax
import numpy as np

D_MODEL = 2048
BATCH = 2
SEQ = 4096
DEPTH = 4
DEC_BATCH = 32
DEC_SEQ = 4
PAST_LEN = 16384
PAGE_SIZE = 128

ATTN_WIDTH = D_MODEL // 2
SSM_WIDTH = D_MODEL - ATTN_WIDTH
HEAD_DIM = 64
N_HEADS = ATTN_WIDTH // HEAD_DIM
N_KV_HEADS = max(1, N_HEADS // 8)
GQA_GROUP = N_HEADS // N_KV_HEADS
KV_WIDTH = N_KV_HEADS * HEAD_DIM
WINDOW = 128
SSM_GROUP = 16
N_SSM_GROUPS = SSM_WIDTH // SSM_GROUP
SSM_STATE = 64
D_IN = ATTN_WIDTH + 2 * KV_WIDTH + SSM_WIDTH
D_FF = ((8 * D_MODEL + 3 * 256 - 1) // (3 * 256)) * 256
EPS = 1e-5
DT_MIN = 1e-3
DT_MAX = 1e-1

kernel_name = 'hymba_swa_sink_s5_decoder_step'


def rms_norm(x, g):
    xf = x.astype(jnp.float32)
    y = xf * lax.rsqrt(jnp.mean(xf * xf, axis=-1, keepdims=True) + EPS)
    return (y * g.astype(jnp.float32)).astype(x.dtype)


def band_mask(tq, tk):
    i = jnp.arange(tq)[:, None]
    j = jnp.arange(tk)[None, :]
    return (j > i) & (j <= i + WINDOW)


def sink_attend(q, k, v, mask, sink):
    s = jnp.einsum('...qkgd,...jkd->...kgqj', q, k).astype(jnp.float32) * (HEAD_DIM ** -0.5)
    s = jnp.where(mask, s, -jnp.inf)
    sk = sink.astype(jnp.float32)[:, :, None, None]
    m = jnp.maximum(jnp.max(s, axis=-1, keepdims=True), sk)
    p = jnp.exp(s - m)
    den = jnp.sum(p, axis=-1, keepdims=True) + jnp.exp(sk - m)
    p = (p / den).astype(v.dtype)
    return jnp.einsum('...kgqj,...jkd->...qkgd', p, v)


def prompt_window_attention(q, k, v, sink):
    b, s = q.shape[0], q.shape[1]
    nb = s // WINDOW
    qb = q.reshape(b, nb, WINDOW, N_KV_HEADS, GQA_GROUP, HEAD_DIM)
    kb = k.reshape(b, nb, WINDOW, N_KV_HEADS, HEAD_DIM)
    vb = v.reshape(b, nb, WINDOW, N_KV_HEADS, HEAD_DIM)
    pad = ((0, 0), (1, 0), (0, 0), (0, 0), (0, 0))
    kk = jnp.concatenate([jnp.pad(kb[:, :-1], pad), kb], axis=2)
    vv = jnp.concatenate([jnp.pad(vb[:, :-1], pad), vb], axis=2)
    first_ok = (jnp.arange(nb) > 0)[:, None, None] | (jnp.arange(2 * WINDOW) >= WINDOW)[None, None, :]
    mask = (band_mask(WINDOW, 2 * WINDOW)[None] & first_ok)[:, None, None]
    out = sink_attend(qb, kk, vv, mask, sink).reshape(b, s, ATTN_WIDTH)
    return out, k[:, -WINDOW:], v[:, -WINDOW:]


def sample_window_attention(q, k, v, sink, kc, vc):
    b, t = q.shape[0], q.shape[1]
    kk = jnp.concatenate([kc.astype(k.dtype), k], axis=1)
    vv = jnp.concatenate([vc.astype(v.dtype), v], axis=1)
    mask = band_mask(t, WINDOW + t)
    out = sink_attend(q, kk, vv, mask, sink).reshape(b, t, ATTN_WIDTH)
    return out, kk[:, -WINDOW:], vv[:, -WINDOW:]


def complex_affine_combine(e1, e2):
    a1r, a1i, b1r, b1i = e1
    a2r, a2i, b2r, b2i = e2
    ar = a1r * a2r - a1i * a2i
    ai = a1r * a2i + a1i * a2r
    br = a2r * b1r - a2i * b1i + b2r
    bi = a2r * b1i + a2i * b1r + b2i
    return (ar, ai, br, bi)


def s5_branch(u, h0r, h0i, a_re, a_im, log_dt, b_re, b_im, c_re, c_im, d, w_glu):
    f32 = jnp.float32
    bsz, t = u.shape[0], u.shape[1]
    uf = u.astype(f32)
    ug = uf.reshape(bsz, t, N_SSM_GROUPS, SSM_GROUP)
    dt = jnp.exp(log_dt.astype(f32))[:, None]
    lr = a_re.astype(f32)
    li = a_im.astype(f32)
    mag = jnp.exp(lr * dt)
    ang = li * dt
    abr = mag * jnp.cos(ang)
    abi = mag * jnp.sin(ang)
    nr = abr - 1.0
    den = lr * lr + li * li
    cr = (nr * lr + abi * li) / den
    ci = (abi * lr - nr * li) / den
    br_ = b_re.astype(f32)
    bi_ = b_im.astype(f32)
    bbr = cr[..., None] * br_ - ci[..., None] * bi_
    bbi = cr[..., None] * bi_ + ci[..., None] * br_
    bur = jnp.einsum('blgc,gpc->blgp', ug, bbr)
    bui = jnp.einsum('blgc,gpc->blgp', ug, bbi)
    ar = jnp.broadcast_to(abr, bur.shape)
    ai = jnp.broadcast_to(abi, bur.shape)
    acr, aci, bcr, bci = lax.associative_scan(complex_affine_combine, (ar, ai, bur, bui), axis=1)
    h0r_ = h0r.astype(f32)[:, None]
    h0i_ = h0i.astype(f32)[:, None]
    hr = acr * h0r_ - aci * h0i_ + bcr
    hi = acr * h0i_ + aci * h0r_ + bci
    y = (jnp.einsum('blgp,gcp->blgc', hr, c_re.astype(f32))
         - jnp.einsum('blgp,gcp->blgc', hi, c_im.astype(f32)))
    y = y.reshape(bsz, t, SSM_WIDTH) + d.astype(f32) * uf
    z = jax.nn.gelu(y, approximate=False).astype(u.dtype)
    out = z * jax.nn.sigmoid(z @ w_glu)
    return out, hr[:, -1], hi[:, -1]


def hybrid_layer(x, l, p, kc, vc, h0r, h0i):
    b, t = x.shape[0], x.shape[1]
    h = rms_norm(x, p['norm_mix'][l])
    z = h @ p['w_in'][l]
    q = z[..., :ATTN_WIDTH].reshape(b, t, N_KV_HEADS, GQA_GROUP, HEAD_DIM)
    k = z[..., ATTN_WIDTH:ATTN_WIDTH + KV_WIDTH].reshape(b, t, N_KV_HEADS, HEAD_DIM)
    v = z[..., ATTN_WIDTH + KV_WIDTH:ATTN_WIDTH + 2 * KV_WIDTH].reshape(b, t, N_KV_HEADS, HEAD_DIM)
    u = z[..., ATTN_WIDTH + 2 * KV_WIDTH:]
    sink = p['attn_sink'][l].reshape(N_KV_HEADS, GQA_GROUP)
    if kc is None:
        a, kn, vn = prompt_window_attention(q, k, v, sink)
    else:
        a, kn, vn = sample_window_attention(q, k, v, sink, kc, vc)
    s, hr, hi = s5_branch(u, h0r, h0i, p['ssm_a_re'][l], p['ssm_a_im'][l], p['ssm_log_dt'][l],
                          p['ssm_b_re'][l], p['ssm_b_im'][l], p['ssm_c_re'][l], p['ssm_c_im'][l],
                          p['ssm_d'][l], p['w_glu'][l])
    mixed = jnp.concatenate([rms_norm(a, p['norm_attn_out'][l]),
                             rms_norm(s, p['norm_ssm_out'][l])], axis=-1) @ p['w_out'][l]
    x = x + mixed
    hf = rms_norm(x, p['norm_ffn'][l])
    x = x + (jax.nn.silu(hf @ p['w_gate'][l]) * (hf @ p['w_up'][l])) @ p['w_down'][l]
    return x, kn, vn, hr, hi


def run_trunk(x, p, cache_k, cache_v, h0_re, h0_im):
    ks, vs, hrs, his = [], [], [], []
    for l in range(DEPTH):
        kc = None if cache_k is None else cache_k[l]
        vc = None if cache_v is None else cache_v[l]
        x, kn, vn, hr, hi = hybrid_layer(x, l, p, kc, vc, h0_re[l], h0_im[l])
        ks.append(kn)
        vs.append(vn)
        hrs.append(hr)
        his.append(hi)
    y = rms_norm(x, p['norm_final'])
    return y, jnp.stack(ks), jnp.stack(vs), jnp.stack(hrs), jnp.stack(his)


def setup_inputs(seed: int = 0) -> dict:
    key = jax.random.key(seed)
    ks = jax.random.split(key, 32)
    f32 = jnp.float32

    def nrm(k, shape, scale):
        return jax.random.normal(k, shape, f32) * scale

    G, P = N_SSM_GROUPS, SSM_STATE
    return {
        'x_prompt': nrm(ks[0], (BATCH, SEQ, D_MODEL), 1.0),
        'x_sample': nrm(ks[1], (DEC_BATCH, DEC_SEQ, D_MODEL), 1.0),
        'cache_k': nrm(ks[2], (DEPTH, DEC_BATCH, WINDOW, N_KV_HEADS, HEAD_DIM), 1.0),
        'cache_v': nrm(ks[3], (DEPTH, DEC_BATCH, WINDOW, N_KV_HEADS, HEAD_DIM), 1.0),
        'state_ssm_re': nrm(ks[4], (DEPTH, DEC_BATCH, G, P), 0.1),
        'state_ssm_im': nrm(ks[5], (DEPTH, DEC_BATCH, G, P), 0.1),
        'norm_mix': 1.0 + nrm(ks[6], (DEPTH, D_MODEL), 0.02),
        'w_in': nrm(ks[7], (DEPTH, D_MODEL, D_IN), D_MODEL ** -0.5),
        'attn_sink': nrm(ks[8], (DEPTH, N_HEADS), 0.5),
        'ssm_a_re': -0.5 * jnp.exp(nrm(ks[9], (DEPTH, G, P), 0.05)),
        'ssm_a_im': math.pi * jnp.arange(P, dtype=f32) + nrm(ks[10], (DEPTH, G, P), 0.01),
        'ssm_log_dt': jax.random.uniform(ks[11], (DEPTH, G), f32, math.log(DT_MIN), math.log(DT_MAX)),
        'ssm_b_re': nrm(ks[12], (DEPTH, G, P, SSM_GROUP), (2 * SSM_GROUP) ** -0.5),
        'ssm_b_im': nrm(ks[13], (DEPTH, G, P, SSM_GROUP), (2 * SSM_GROUP) ** -0.5),
        'ssm_c_re': nrm(ks[14], (DEPTH, G, SSM_GROUP, P), (2 * P) ** -0.5),
        'ssm_c_im': nrm(ks[15], (DEPTH, G, SSM_GROUP, P), (2 * P) ** -0.5),
        'ssm_d': nrm(ks[16], (DEPTH, SSM_WIDTH), 1.0),
        'w_glu': nrm(ks[17], (DEPTH, SSM_WIDTH, SSM_WIDTH), SSM_WIDTH ** -0.5),
        'norm_attn_out': 1.0 + nrm(ks[18], (DEPTH, ATTN_WIDTH), 0.02),
        'norm_ssm_out': 1.0 + nrm(ks[19], (DEPTH, SSM_WIDTH), 0.02),
        'w_out': nrm(ks[20], (DEPTH, ATTN_WIDTH + SSM_WIDTH, D_MODEL), (ATTN_WIDTH + SSM_WIDTH) ** -0.5),
        'norm_ffn': 1.0 + nrm(ks[21], (DEPTH, D_MODEL), 0.02),
        'w_gate': nrm(ks[22], (DEPTH, D_MODEL, D_FF), D_MODEL ** -0.5),
        'w_up': nrm(ks[23], (DEPTH, D_MODEL, D_FF), D_MODEL ** -0.5),
        'w_down': nrm(ks[24], (DEPTH, D_FF, D_MODEL), D_FF ** -0.5),
        'norm_final': 1.0 + nrm(ks[25], (D_MODEL,), 0.02),
    }


def reference(x_prompt, x_sample, cache_k, cache_v, state_ssm_re, state_ssm_im,
              norm_mix, w_in, attn_sink, ssm_a_re, ssm_a_im, ssm_log_dt,
              ssm_b_re, ssm_b_im, ssm_c_re, ssm_c_im, ssm_d, w_glu,
              norm_attn_out, norm_ssm_out, w_out, norm_ffn, w_gate, w_up, w_down,
              norm_final):
    p = dict(norm_mix=norm_mix, w_in=w_in, attn_sink=attn_sink,
             ssm_a_re=ssm_a_re, ssm_a_im=ssm_a_im, ssm_log_dt=ssm_log_dt,
             ssm_b_re=ssm_b_re, ssm_b_im=ssm_b_im, ssm_c_re=ssm_c_re, ssm_c_im=ssm_c_im,
             ssm_d=ssm_d, w_glu=w_glu, norm_attn_out=norm_attn_out, norm_ssm_out=norm_ssm_out,
             w_out=w_out, norm_ffn=norm_ffn, w_gate=w_gate, w_up=w_up, w_down=w_down,
             norm_final=norm_final)
    zeros_state = jnp.zeros((DEPTH, x_prompt.shape[0], N_SSM_GROUPS, SSM_STATE), jnp.float32)
    y_prompt, k_p, v_p, hr_p, hi_p = run_trunk(x_prompt, p, None, None, zeros_state, zeros_state)
    y_sample, k_s, v_s, hr_s, hi_s = run_trunk(x_sample, p, cache_k, cache_v, state_ssm_re, state_ssm_im)
    return (y_prompt, y_sample, k_p, v_p, hr_p, hi_p, k_s, v_s, hr_s, hi_s)
```

```cpp
#include <hip/hip_runtime.h>
#include <hip/hip_cooperative_groups.h>
#include <cstdio>
#include <cstdint>
namespace cg = cooperative_groups;

#ifndef MK_SINGLE
#define MK_SINGLE 0
#endif

constexpr int DM = 2048, SEQ = 4096, NBATCH = 2, DEPTH = 4, DECB = 32, DECS = 4;
constexpr int AW = 1024, SW = 1024, HD = 64, NKV = 2, WIN = 128, NG = 64, SP = 64;
constexpr int DIN = 2304, DFF = 5632;
constexpr int MPR = NBATCH * SEQ, MSM = DECB * DECS, MT = MPR + MSM, MP = 8448;
constexpr float EPS = 1e-5f;
constexpr int ZQ = 0, ZK = 1024, ZV = 1152, ZU = 1280;

enum { I_XP = 0, I_XS, I_CK, I_CV, I_SRE, I_SIM, I_NMIX, I_WIN, I_SINK, I_ARE, I_AIM, I_LDT, I_BRE, I_BIM, I_CRE, I_CIM, I_D, I_WGLU, I_NATT, I_NSSM, I_WOUT, I_NFFN, I_WG, I_WU, I_WD, I_NFIN, N_IN };

constexpr size_t O_YP = 0, O_YS = O_YP + (size_t)MPR * DM, O_KP = O_YS + (size_t)MSM * DM, O_VP = O_KP + (size_t)DEPTH * NBATCH * WIN * 128,
                 O_HRP = O_VP + (size_t)DEPTH * NBATCH * WIN * 128, O_HIP = O_HRP + (size_t)DEPTH * NBATCH * NG * SP, O_KS = O_HIP + (size_t)DEPTH * NBATCH * NG * SP,
                 O_VS = O_KS + (size_t)DEPTH * DECB * WIN * 128, O_HRS = O_VS + (size_t)DEPTH * DECB * WIN * 128, O_HIS = O_HRS + (size_t)DEPTH * DECB * NG * SP,
                 O_END = O_HIS + (size_t)DEPTH * DECB * NG * SP;

constexpr size_t al256(size_t x) { return (x + 255) & ~(size_t)255; }
constexpr size_t WB_IN = (size_t)DIN * DM * 2, WB_GLU = (size_t)SW * SW * 2, WB_OUT = (size_t)DM * DM * 2, WB_GU = (size_t)2 * DFF * DM * 2, WB_DN = (size_t)DM * DFF * 2;
constexpr size_t WL_IN = 0, WL_GLU = WL_IN + WB_IN, WL_OUT = WL_GLU + WB_GLU, WL_GU = WL_OUT + WB_OUT, WL_DN = WL_GU + WB_GU, WL_SIZE = WL_DN + WB_DN;
constexpr size_t WS_W = 0;
constexpr size_t WS_XF = al256(WS_W + DEPTH * WL_SIZE);
constexpr size_t WS_XB = al256(WS_XF + (size_t)MP * DM * 4);
constexpr size_t WS_Z = al256(WS_XB + (size_t)MP * DM * 2);
constexpr size_t WS_CAT = al256(WS_Z + (size_t)MP * DIN * 2);
constexpr size_t WS_ZS = al256(WS_CAT + (size_t)MP * DM * 2);
constexpr size_t WS_H = al256(WS_ZS + (size_t)MP * SW * 2);
constexpr size_t WS_SS = al256(WS_H + (size_t)MP * DFF * 2);
constexpr int NSS = 17;
constexpr size_t WS_SP = al256(WS_SS + (size_t)NSS * MP * 32 * 4);
constexpr size_t SPL = (size_t)(2 * NG * SP + 2 * NG * SP * 16);
constexpr size_t WS_SC = al256(WS_SP + DEPTH * SPL * 4);
constexpr size_t WS_END = al256(WS_SC + (size_t)NBATCH * NG * 32 * SP * 8);

#define LAS __attribute__((address_space(3)))
typedef unsigned short bf16_t;
typedef short bf16x8 __attribute__((ext_vector_type(8)));
typedef short s16x4 __attribute__((ext_vector_type(4)));
typedef float f32x4 __attribute__((ext_vector_type(4)));
typedef float f32x16 __attribute__((ext_vector_type(16)));
typedef unsigned u32x4 __attribute__((ext_vector_type(4)));
typedef unsigned u32x2 __attribute__((ext_vector_type(2)));

__device__ __forceinline__ unsigned f2bf(float f) { unsigned u = __builtin_bit_cast(unsigned, f); return (u + 0x7fffu + ((u >> 16) & 1u)) >> 16; }
__device__ __forceinline__ unsigned pk2(float lo, float hi) { return f2bf(lo) | (f2bf(hi) << 16); }
__device__ __forceinline__ float bflo(unsigned w) { return __builtin_bit_cast(float, w << 16); }
__device__ __forceinline__ float bfhi(unsigned w) { return __builtin_bit_cast(float, w & 0xffff0000u); }
__device__ __forceinline__ float bf2f(bf16_t b) { return __builtin_bit_cast(float, (unsigned)b << 16); }
__device__ __forceinline__ float wave_sum(float v) {
#pragma unroll
    for (int o = 1; o < 64; o <<= 1) v += __shfl_xor(v, o);
    return v;
}
namespace pg8 {
#define PG8_LAS __attribute__((address_space(3)))
typedef unsigned short bf16_t;
typedef short bf16x8 __attribute__((ext_vector_type(8)));
typedef float f32x4 __attribute__((ext_vector_type(4)));
typedef unsigned u32x4 __attribute__((ext_vector_type(4)));
constexpr int BM = 256, BK = 64, HALF = 128, HTB = HALF * BK * 2  , STAGE_BYTES = 8 * HTB, NXCD = 8, WGM = 8;

__host__ __device__ __forceinline__ int lds_byte(int r, int c) { const int st = (r >> 4) * 2 + (c >> 5), rr = r & 15, cc = c & 31, ob = rr * 64 + cc * 2; return st * 1024 + (ob ^ (((ob >> 9) & 1) << 5)); }
__host__ __device__ __forceinline__ void stage_rc(int b, int& R, int& C) { const int st = b / 1024, sb = b % 1024, swz = sb ^ (((sb >> 9) & 1) << 5); R = (st >> 1) * 16 + swz / 64; C = (st & 1) * 32 + (swz % 64) / 2; }
__host__ __device__ __forceinline__ int perm32(int rho) { const int n = rho >> 4, i = rho & 15; return 8 * (i >> 2) + 4 * n + (i & 3); }

struct Unit { int pm, pn; };
struct Gemm { const bf16_t* A; const bf16_t* Bt; int M, N, K; };

struct StaticOrder {
    int nM, nN, nwg, G, c;
    __host__ __device__ void init(int M, int N, int G_, int c_) { nM = M / BM; nN = N / BM; nwg = nM * nN; G = G_; c = c_; }
    __host__ __device__ bool next(int i, Unit& u) const {
        const long L = (long)i * G + c; if (L >= nwg) return false;
        int wgid = (int)L; { const int q = nwg / NXCD, r = nwg % NXCD, xcd = wgid % NXCD, off = wgid / NXCD; wgid = (xcd < r ? xcd * (q + 1) : r * (q + 1) + (xcd - r) * q) + off; }
        const int nig = WGM * nN, gid = wgid / nig, fm = gid * WGM, gsz = (nM - fm) < WGM ? (nM - fm) : WGM;
        u.pm = fm + ((wgid % nig) % gsz); u.pn = (wgid % nig) / gsz; return true;
    }
    __device__ __forceinline__ void a_ready(const Unit&) const {}
    __device__ __forceinline__ void done(const Unit&) const {}
};

__device__ __forceinline__ unsigned cvt_pk_bf16(float lo, float hi) { unsigned r; asm volatile("v_cvt_pk_bf16_f32 %0, %1, %2" : "=v"(r) : "v"(lo), "v"(hi)); return r; }
typedef float f32x2 __attribute__((ext_vector_type(2)));
__device__ __forceinline__ float rs_of(const float* ss, int r, float invn) { return rsqrtf(ss[r] * invn + 1e-5f); }

struct EpiIn {
    static constexpr bool PERM = true, AFTER_DRAIN = false, MIDK = false;
    bf16_t* O; int ldc; const LAS float* rst;
    __device__ __forceinline__ void operator()(const f32x4 (&acc)[2][2][4][2], const Unit& u, int ui, int wr, int wc, int fr, int fq) const {
        const int row0 = u.pm * BM + wr * 64 + fr, col0 = u.pn * BM + wc * 32 + 8 * fq, lr0 = (ui & 7) * 256 + wr * 64 + fr;
#pragma unroll
        for (int ai = 0; ai < 2; ++ai)
#pragma unroll
            for (int m = 0; m < 4; ++m) { const int r = row0 + ai * HALF + m * 16; const float rs = rst[lr0 + ai * HALF + m * 16]; bf16_t* rowp = O + (size_t)r * ldc + col0;
#pragma unroll
                for (int bj = 0; bj < 2; ++bj) { const f32x4 v0 = acc[ai][bj][m][0] * rs, v1 = acc[ai][bj][m][1] * rs;
                    u32x4 w; w.x = cvt_pk_bf16(v0[0], v0[1]); w.y = cvt_pk_bf16(v0[2], v0[3]); w.z = cvt_pk_bf16(v1[0], v1[1]); w.w = cvt_pk_bf16(v1[2], v1[3]);
                    *(u32x4*)(rowp + bj * HALF) = w; } }
    }
};
struct EpiGlu {
    static constexpr bool PERM = true, AFTER_DRAIN = false, MIDK = false;
    const bf16_t* ZS; int ldz; bf16_t* O; int ldc; float* ssq;
    __device__ __forceinline__ void operator()(const f32x4 (&acc)[2][2][4][2], const Unit& u, int ui, int wr, int wc, int fr, int fq) const {
        const int row0 = u.pm * BM + wr * 64 + fr, col0 = u.pn * BM + wc * 32 + 8 * fq;
#pragma unroll
        for (int ai = 0; ai < 2; ++ai)
#pragma unroll
            for (int m = 0; m < 4; ++m) { const int r = row0 + ai * HALF + m * 16; float sq = 0.f;
#pragma unroll
                for (int bj = 0; bj < 2; ++bj) { const u32x4 zv = *(const u32x4*)(ZS + (size_t)r * ldz + col0 + bj * HALF);
                    const f32x4 a0 = acc[ai][bj][m][0], a1 = acc[ai][bj][m][1];
                    float z[8] = {bflo(zv.x), bfhi(zv.x), bflo(zv.y), bfhi(zv.y), bflo(zv.z), bfhi(zv.z), bflo(zv.w), bfhi(zv.w)};
                    float g[8] = {a0[0], a0[1], a0[2], a0[3], a1[0], a1[1], a1[2], a1[3]};
#pragma unroll
                    for (int e = 0; e < 8; ++e) { z[e] = z[e] / (1.0f + __expf(-g[e])); sq += z[e] * z[e]; }
                    u32x4 w; w.x = cvt_pk_bf16(z[0], z[1]); w.y = cvt_pk_bf16(z[2], z[3]); w.z = cvt_pk_bf16(z[4], z[5]); w.w = cvt_pk_bf16(z[6], z[7]);
                    *(u32x4*)(O + (size_t)r * ldc + col0 + bj * HALF) = w; }
                sq += __shfl_xor(sq, 16); sq += __shfl_xor(sq, 32);
                if (fq == 0) ssq[(size_t)r * 32 + u.pn * 4 + wc] = sq; }
    }
};
template <bool MID> struct EpiRes {
    static constexpr bool PERM = false, AFTER_DRAIN = false, MIDK = MID;
    float* XF; bf16_t* XB; int ldc; float* ssq; const LAS float* rt; const LAS float* rst; int tmid;
    __device__ __forceinline__ void mid(f32x4 (&acc)[2][2][4][2], int ui, int wr, int fr) const {
        const int row0 = (ui & 7) * 256 + wr * 64 + fr;
#pragma unroll
        for (int ai = 0; ai < 2; ++ai)
#pragma unroll
            for (int m = 0; m < 4; ++m) { const int r = row0 + ai * HALF + m * 16; const float f = rt[r];
#pragma unroll
                for (int bj = 0; bj < 2; ++bj)
#pragma unroll
                    for (int n = 0; n < 2; ++n) acc[ai][bj][m][n] = acc[ai][bj][m][n] * f; }
    }
    __device__ __forceinline__ void operator()(const f32x4 (&acc)[2][2][4][2], const Unit& u, int ui, int wr, int wc, int fr, int fq) const {
        const int row0 = u.pm * BM + wr * 64 + fr, col0 = u.pn * BM + wc * 32 + 4 * fq, lr0 = (ui & 7) * 256 + wr * 64 + fr;
#pragma unroll
        for (int ai = 0; ai < 2; ++ai)
#pragma unroll
            for (int m = 0; m < 4; ++m) { const int r = row0 + ai * HALF + m * 16; const float sc = MID ? rst[lr0 + ai * HALF + m * 16] : 1.0f; float sq = 0.f;
                const size_t off = (size_t)r * ldc + col0;
#pragma unroll
                for (int bj = 0; bj < 2; ++bj)
#pragma unroll
                    for (int n = 0; n < 2; ++n) { const size_t o = off + bj * HALF + n * 16; const f32x4 x = *(const f32x4*)(XF + o) + acc[ai][bj][m][n] * sc;
                        *(f32x4*)(XF + o) = x; sq += (x[0] * x[0] + x[1] * x[1]) + (x[2] * x[2] + x[3] * x[3]);
                        u32x2 w; w.x = cvt_pk_bf16(x[0], x[1]); w.y = cvt_pk_bf16(x[2], x[3]); *(u32x2*)(XB + o) = w; }
                sq += __shfl_xor(sq, 16); sq += __shfl_xor(sq, 32);
                if (fq == 0) ssq[(size_t)r * 32 + u.pn * 4 + wc] = sq; }
    }
};
struct EpiGU {
    static constexpr bool PERM = true, AFTER_DRAIN = false, MIDK = false;
    bf16_t* O; int ldc; const LAS float* rst;
    __device__ __forceinline__ void operator()(const f32x4 (&acc)[2][2][4][2], const Unit& u, int ui, int wr, int wc, int fr, int fq) const {
        const int row0 = u.pm * BM + wr * 64 + fr, col0 = u.pn * HALF + wc * 32 + 8 * fq, lr0 = (ui & 7) * 256 + wr * 64 + fr;
#pragma unroll
        for (int ai = 0; ai < 2; ++ai)
#pragma unroll
            for (int m = 0; m < 4; ++m) { const int r = row0 + ai * HALF + m * 16; const float rs = rst[lr0 + ai * HALF + m * 16];
                float h[8];
#pragma unroll
                for (int n = 0; n < 2; ++n)
#pragma unroll
                    for (int e = 0; e < 4; ++e) { const float g = acc[ai][0][m][n][e] * rs, v = acc[ai][1][m][n][e] * rs; h[n * 4 + e] = g / (1.0f + __expf(-g)) * v; }
                u32x4 w; w.x = cvt_pk_bf16(h[0], h[1]); w.y = cvt_pk_bf16(h[2], h[3]); w.z = cvt_pk_bf16(h[4], h[5]); w.w = cvt_pk_bf16(h[6], h[7]);
                *(u32x4*)(O + (size_t)r * ldc + col0) = w; }
    }
};
template <class Epi, class Sched, bool ALIGN_EPI = false, bool SP2 = false>
__device__ __forceinline__ void gemm_phase(PG8_LAS unsigned char* lds, const Gemm g, const Sched& S, const Epi& E, const int tid) {
    const int wid = __builtin_amdgcn_readfirstlane(tid >> 6), lane = tid & 63, wr = wid >> 2, wc = wid & 3, fr = lane & 15, fq = lane >> 4;
    const int K = g.K, nt = K / BK;
    unsigned voffA[2], voffB[2];
#pragma unroll
    for (int i = 0; i < 2; ++i) { int R, C; stage_rc(tid * 16 + i * 8192, R, C); const int Rb = Epi::PERM ? ((R & ~31) + perm32(R & 31)) : R;
        voffA[i] = (unsigned)(R * K + C) * 2u; voffB[i] = (unsigned)(Rb * K + C) * 2u; }
    const size_t kstep = (size_t)(BK * 2);
    const size_t hstep = (size_t)HALF * K * 2;
    const size_t tstep = 2 * hstep;
    const unsigned ldsw = (unsigned)wid * 1024u;
    const int aoff = lds_byte(wr * 64 + fr, fq * 8), boff = lds_byte(wc * 32 + fr, fq * 8);
#define PG8_SA(b, h) (((b) * 2 + (h)) * HTB)
#define PG8_SB(b, h) ((4 + (b) * 2 + (h)) * HTB)
#define PG8_STAGE(bufoff, gbase, voff) do { _Pragma("unroll") for (int _i = 0; _i < 2; ++_i) \
        __builtin_amdgcn_global_load_lds((const unsigned*)((const char*)(gbase) + (voff)[_i]), (PG8_LAS unsigned*)(lds + (bufoff) + ldsw + _i * 8192), 16, 0, 0); } while (0)
#define PG8_LDA(dst, b, h) do { _Pragma("unroll") for (int m = 0; m < 4; ++m) _Pragma("unroll") for (int k = 0; k < 2; ++k) dst[m][k] = *(const PG8_LAS bf16x8*)(lds + PG8_SA(b, h) + aoff + m * 2048 + k * 1024); } while (0)
#define PG8_LDB(dst, b, h) do { _Pragma("unroll") for (int n = 0; n < 2; ++n) _Pragma("unroll") for (int k = 0; k < 2; ++k) dst[n][k] = *(const PG8_LAS bf16x8*)(lds + PG8_SB(b, h) + boff + n * 2048 + k * 1024); } while (0)
#define PG8_MMA(ai, bj, At, Bt) do { __builtin_amdgcn_s_setprio(1); _Pragma("unroll") for (int m = 0; m < 4; ++m) _Pragma("unroll") for (int n = 0; n < 2; ++n) _Pragma("unroll") for (int k = 0; k < 2; ++k) \
        acc[ai][bj][m][n] = __builtin_amdgcn_mfma_f32_16x16x32_bf16(Bt[n][k], At[m][k], acc[ai][bj][m][n], 0, 0, 0); __builtin_amdgcn_s_setprio(0); } while (0)
#define PG8_WAIT_V(n) asm volatile("s_waitcnt vmcnt(" #n ")" ::: "memory")
#define PG8_WAIT_L(n) asm volatile("s_waitcnt lgkmcnt(" #n ")" ::: "memory")
#define PG8_BAR __builtin_amdgcn_s_barrier()
#define PG8_SCHED __builtin_amdgcn_sched_barrier(0)
    Unit cur, nxt; int ui = 0;
    if (!S.next(0, cur)) return;
    f32x4 acc[2][2][4][2];
#pragma unroll
    for (int a = 0; a < 2; ++a)
#pragma unroll
        for (int b = 0; b < 2; ++b)
#pragma unroll
            for (int m = 0; m < 4; ++m)
#pragma unroll
                for (int n = 0; n < 2; ++n) acc[a][b][m][n] = (f32x4){0.f, 0.f, 0.f, 0.f};
    bf16x8 At[4][2], B0[2][2], B1[2][2];
    const char* cA = (const char*)g.A + (size_t)cur.pm * tstep; const char* cB = (const char*)g.Bt + (size_t)cur.pn * tstep;
    S.a_ready(cur);
    if constexpr (SP2) {
        PG8_STAGE(PG8_SB(0, 0), cB, voffB); PG8_STAGE(PG8_SB(0, 1), cB + hstep, voffB); PG8_STAGE(PG8_SA(0, 0), cA, voffA); PG8_STAGE(PG8_SA(0, 1), cA + hstep, voffA);
        if (wr == 1) PG8_BAR;
        PG8_WAIT_V(2); PG8_BAR;
        PG8_STAGE(PG8_SB(1, 0), cB + kstep, voffB); PG8_STAGE(PG8_SA(1, 0), cA + kstep, voffA); PG8_STAGE(PG8_SB(1, 1), cB + hstep + kstep, voffB);
        PG8_WAIT_V(6); PG8_BAR;
    } else {
        PG8_STAGE(PG8_SB(0, 0), cB, voffB); PG8_STAGE(PG8_SA(0, 0), cA, voffA); PG8_STAGE(PG8_SB(0, 1), cB + hstep, voffB); PG8_STAGE(PG8_SA(0, 1), cA + hstep, voffA);
        if (wr == 1) PG8_BAR;
        PG8_WAIT_V(4); PG8_BAR;
        PG8_STAGE(PG8_SB(1, 0), cB + kstep, voffB); PG8_STAGE(PG8_SA(1, 0), cA + kstep, voffA); PG8_STAGE(PG8_SB(1, 1), cB + hstep + kstep, voffB);
        PG8_WAIT_V(6); PG8_BAR;
    }
    for (;;) {
        const bool has_next = S.next(ui + 1, nxt);
        const char* nA = has_next ? (const char*)g.A + (size_t)nxt.pm * tstep : cA; const char* nB = has_next ? (const char*)g.Bt + (size_t)nxt.pn * tstep : cB;
        for (int t = 0; t < nt; t += 2) {
            const bool last = (t == nt - 2);
            const char* a1 = cA + (size_t)(t + 1) * kstep;
            const char* a2 = last ? nA : cA + (size_t)(t + 2) * kstep; const char* b2 = last ? nB : cB + (size_t)(t + 2) * kstep;
            const char* a3 = a2 + kstep; const char* b3 = b2 + kstep;
            if (last && has_next) S.a_ready(nxt);
            if constexpr (Epi::MIDK) { if (t == E.tmid) E.mid(acc, ui, wr, fr); }
            if constexpr (SP2) {
            PG8_LDB(B0, 0, 0); PG8_LDB(B1, 0, 1); PG8_SCHED; PG8_LDA(At, 0, 0); PG8_STAGE(PG8_SA(1, 1), a1 + hstep, voffA);
            PG8_WAIT_V(8); PG8_WAIT_L(0); PG8_BAR; PG8_MMA(0, 0, At, B0); PG8_MMA(0, 1, At, B1); PG8_BAR; PG8_SCHED;
            PG8_LDA(At, 0, 1); PG8_STAGE(PG8_SB(0, 0), b2, voffB); PG8_STAGE(PG8_SB(0, 1), b2 + hstep, voffB); PG8_STAGE(PG8_SA(0, 0), a2, voffA);
            PG8_WAIT_V(8); PG8_WAIT_L(0); PG8_BAR; PG8_MMA(1, 0, At, B0); PG8_MMA(1, 1, At, B1); PG8_BAR; PG8_SCHED;
            PG8_LDB(B0, 1, 0); PG8_LDB(B1, 1, 1); PG8_SCHED; PG8_LDA(At, 1, 0); PG8_STAGE(PG8_SA(0, 1), a2 + hstep, voffA);
            PG8_WAIT_V(8); PG8_WAIT_L(0); PG8_BAR; PG8_MMA(0, 0, At, B0); PG8_MMA(0, 1, At, B1); PG8_BAR; PG8_SCHED;
            PG8_LDA(At, 1, 1); PG8_STAGE(PG8_SB(1, 0), b3, voffB); PG8_STAGE(PG8_SB(1, 1), b3 + hstep, voffB); PG8_STAGE(PG8_SA(1, 0), a3, voffA);
            PG8_WAIT_V(8); PG8_WAIT_L(0); PG8_BAR; PG8_MMA(1, 0, At, B0); PG8_MMA(1, 1, At, B1); PG8_BAR; PG8_SCHED;
            } else {
            PG8_LDB(B0, 0, 0); PG8_SCHED; PG8_LDA(At, 0, 0); PG8_STAGE(PG8_SA(1, 1), a1 + hstep, voffA);
            PG8_WAIT_L(8); PG8_BAR; PG8_WAIT_L(0); PG8_MMA(0, 0, At, B0); PG8_BAR; PG8_SCHED;
            PG8_LDB(B1, 0, 1); PG8_STAGE(PG8_SB(0, 0), b2, voffB);
            PG8_BAR; PG8_WAIT_L(0); PG8_MMA(0, 1, At, B1); PG8_BAR;
            PG8_LDA(At, 0, 1); PG8_STAGE(PG8_SA(0, 0), a2, voffA);
            PG8_BAR; PG8_WAIT_L(0); PG8_MMA(1, 0, At, B0); PG8_BAR; PG8_SCHED;
            PG8_STAGE(PG8_SB(0, 1), b2 + hstep, voffB);
            PG8_WAIT_V(6); PG8_BAR; PG8_MMA(1, 1, At, B1); PG8_BAR;
            PG8_LDB(B0, 1, 0); PG8_SCHED; PG8_LDA(At, 1, 0); PG8_STAGE(PG8_SA(0, 1), a2 + hstep, voffA);
            PG8_WAIT_L(8); PG8_BAR; PG8_WAIT_L(0); PG8_MMA(0, 0, At, B0); PG8_BAR; PG8_SCHED;
            PG8_LDB(B1, 1, 1); PG8_STAGE(PG8_SB(1, 0), b3, voffB);
            PG8_BAR; PG8_WAIT_L(0); PG8_MMA(0, 1, At, B1); PG8_BAR;
            PG8_LDA(At, 1, 1); PG8_STAGE(PG8_SA(1, 0), a3, voffA);
            PG8_BAR; PG8_WAIT_L(0); PG8_MMA(1, 0, At, B0); PG8_BAR; PG8_SCHED;
            PG8_STAGE(PG8_SB(1, 1), b3 + hstep, voffB);
            PG8_WAIT_V(6); PG8_BAR; PG8_MMA(1, 1, At, B1); PG8_BAR;
            }
        }
        if constexpr (ALIGN_EPI) { if (wr == 0) PG8_BAR; }
        if constexpr (!Epi::AFTER_DRAIN) { E(acc, cur, ui, wr, wc, fr, fq); S.done(cur); }
        if (!has_next) break;
#pragma unroll
        for (int a = 0; a < 2; ++a)
#pragma unroll
            for (int b = 0; b < 2; ++b)
#pragma unroll
                for (int m = 0; m < 4; ++m)
#pragma unroll
                    for (int n = 0; n < 2; ++n) acc[a][b][m][n] = (f32x4){0.f, 0.f, 0.f, 0.f};
        cur = nxt; cA = nA; cB = nB; ++ui;
        if constexpr (ALIGN_EPI) { if (wr == 1) PG8_BAR; }
    }
    PG8_WAIT_V(0);
    if constexpr (!ALIGN_EPI) { if (wr == 0) PG8_BAR; }
    PG8_BAR;
    if constexpr (Epi::AFTER_DRAIN) { E.fused(acc, cur, wr, wc, fr, fq, lds, wid, lane); S.done(cur); }
#undef PG8_SA
#undef PG8_SB
#undef PG8_STAGE
#undef PG8_LDA
#undef PG8_LDB
#undef PG8_MMA
#undef PG8_WAIT_V
#undef PG8_WAIT_L
#undef PG8_BAR
#undef PG8_SCHED
}
}

#ifndef PHMASK
#define PHMASK 1023
#endif
constexpr int NWAVES = 8, NTHR = 512;
constexpr int LDS_BYTES = 147456;
constexpr int SCAN_WAVE_BYTES = 17408, HB_STRIDE = 132;
constexpr int KS_STRIDE = 144, VT_STRIDE = 400, ATT_V_OFF = 192 * KS_STRIDE;
constexpr int N_PHASES = 2 + 7 * DEPTH;

#define CAS __attribute__((address_space(4)))
typedef const float* cfp;
struct Params { const float* in[N_IN]; float* out; unsigned char* ws; int ph_lo, ph_hi; };

struct Frame {
    LAS unsigned char* lds; int tid, lane, wave, G, bid;
    const CAS cfp* in; float* out; unsigned char* ws;
    float* XF; bf16_t* XB; bf16_t* Z; bf16_t* CAT; bf16_t* ZS; bf16_t* H; float* SS; float* SPp; float* SC;
};
#define LDS_WAIT() asm volatile("s_waitcnt lgkmcnt(0)" ::: "memory")

__device__ __forceinline__ void p0_transpose_item(const float* W, int K, int N, bf16_t* WT, int item, const float* g1, const float* g2, int split, int mode, LAS float* scr, int lane) {
    const int nblk = N / 32, kb = item / nblk, nb = item % nblk, k0 = 64 * kb, n0 = 32 * nb;
#pragma unroll 8
    for (int i = 0; i < 32; ++i) { const int kk = 2 * i + (lane >> 5), k = k0 + kk; const float g = g1 ? ((k < split) ? g1[k] : g2[k - split]) : 1.0f;
        scr[kk * 33 + (lane & 31)] = W[(size_t)k * N + n0 + (lane & 31)] * g; }
    LDS_WAIT();
    const int c = lane & 7;
#pragma unroll
    for (int j = 0; j < 4; ++j) { const int n = (lane >> 3) + 8 * j; const LAS float* s = scr + (8 * c) * 33 + n;
        u32x4 o; o.x = pk2(s[0 * 33], s[1 * 33]); o.y = pk2(s[2 * 33], s[3 * 33]); o.z = pk2(s[4 * 33], s[5 * 33]); o.w = pk2(s[6 * 33], s[7 * 33]);
        const int nn = n0 + n; const int drow = (mode == 0) ? nn : (((nn >> 7) << 8) + (nn & 127) + (mode == 2 ? 128 : 0));
        *(u32x4*)(WT + (size_t)drow * K + k0 + 8 * c) = o; }
    LDS_WAIT();
}
__device__ __forceinline__ void phase_prologue(Frame& F) {
    LAS float* scr = (LAS float*)(F.lds + F.wave * 16384);
    const int gw = F.bid * NWAVES + F.wave, NGW = F.G * NWAVES;
    constexpr int IT_IN = (DM / 64) * (DIN / 32), IT_GLU = (SW / 64) * (SW / 32), IT_OUT = (DM / 64) * (DM / 32), IT_G = (DM / 64) * (DFF / 32), IT_D = (DFF / 64) * (DM / 32);
    constexpr int IT_L = IT_IN + IT_GLU + IT_OUT + 2 * IT_G + IT_D;
#pragma unroll 1
    for (int it = gw; it < DEPTH * IT_L; it += NGW) {
        const int l = it / IT_L; int r = it % IT_L;
        bf16_t* wl = (bf16_t*)(F.ws + WS_W + (size_t)l * WL_SIZE);
        const float* W; const float* g1 = nullptr; const float* g2 = nullptr; bf16_t* WT; int K, N, split = 0, mode = 0;
        if (r < IT_IN) { W = F.in[I_WIN] + (size_t)l * DM * DIN; K = DM; N = DIN; WT = wl + WL_IN / 2; g1 = F.in[I_NMIX] + l * DM; split = DM; }
        else if ((r -= IT_IN) < IT_GLU) { W = F.in[I_WGLU] + (size_t)l * SW * SW; K = SW; N = SW; WT = wl + WL_GLU / 2; }
        else if ((r -= IT_GLU) < IT_OUT) { W = F.in[I_WOUT] + (size_t)l * DM * DM; K = DM; N = DM; WT = wl + WL_OUT / 2; g1 = F.in[I_NATT] + l * AW; g2 = F.in[I_NSSM] + l * SW; split = AW; }
        else if ((r -= IT_OUT) < IT_G) { W = F.in[I_WG] + (size_t)l * DM * DFF; K = DM; N = DFF; WT = wl + WL_GU / 2; g1 = F.in[I_NFFN] + l * DM; split = DM; mode = 1; }
        else if ((r -= IT_G) < IT_G) { W = F.in[I_WU] + (size_t)l * DM * DFF; K = DM; N = DFF; WT = wl + WL_GU / 2; g1 = F.in[I_NFFN] + l * DM; split = DM; mode = 2; }
        else { r -= IT_G; W = F.in[I_WD] + (size_t)l * DFF * DM; K = DFF; N = DM; WT = wl + WL_DN / 2; }
        p0_transpose_item(W, K, N, WT, r, g1, g2, split, mode, scr, F.lane);
    }
    for (int m = gw; m < MP; m += NGW) {
        f32x4* xf = (f32x4*)(F.XF + (size_t)m * DM) + F.lane; u32x2* xb = (u32x2*)(F.XB + (size_t)m * DM) + F.lane;
        if (m < MT) {
            const f32x4* src = (const f32x4*)(m < MPR ? F.in[I_XP] + (size_t)m * DM : F.in[I_XS] + (size_t)(m - MPR) * DM) + F.lane;
            float s = 0.f;
#pragma unroll
            for (int j = 0; j < 8; ++j) { const f32x4 v = src[64 * j]; s += (v[0] * v[0] + v[1] * v[1]) + (v[2] * v[2] + v[3] * v[3]); xf[64 * j] = v; u32x2 w; w.x = pk2(v[0], v[1]); w.y = pk2(v[2], v[3]); xb[64 * j] = w; }
            s = wave_sum(s); if (F.lane < 32) F.SS[(size_t)m * 32 + F.lane] = (F.lane == 0) ? s : 0.f;
        } else {
#pragma unroll
            for (int j = 0; j < 8; ++j) { xf[64 * j] = (f32x4){0.f, 0.f, 0.f, 0.f}; xb[64 * j] = (u32x2){0u, 0u}; }
            if (F.lane < 32) F.SS[(size_t)m * 32 + F.lane] = 0.f;
        }
    }
    const int gt = F.bid * NTHR + F.tid, NGT = F.G * NTHR;
    for (int i = gt; i < DEPTH * NG * SP; i += NGT) {
        const int l = i / (NG * SP), gp = i % (NG * SP), g = gp / SP;
        const double dt = exp((double)F.in[I_LDT][l * NG + g]), lr = F.in[I_ARE][i], li = F.in[I_AIM][i];
        const double mag = exp(lr * dt), ang = li * dt, abr = mag * cos(ang), abi = mag * sin(ang), nr = abr - 1.0, den = lr * lr + li * li;
        const double cr = (nr * lr + abi * li) / den, ci = (abi * lr - nr * li) / den;
        float* sp = F.SPp + (size_t)l * SPL;
        sp[gp] = (float)abr; sp[NG * SP + gp] = (float)abi;
        const float* bre = F.in[I_BRE] + (size_t)i * 16; const float* bim = F.in[I_BIM] + (size_t)i * 16;
#pragma unroll
        for (int c = 0; c < 16; ++c) { const double br = bre[c], bi = bim[c]; sp[2 * NG * SP + gp * 16 + c] = (float)(cr * br - ci * bi); sp[2 * NG * SP + NG * SP * 16 + gp * 16 + c] = (float)(cr * bi + ci * br); }
    }
}

#define MFMA32(a, b, c) __builtin_amdgcn_mfma_f32_32x32x16_bf16((a), (b), (c), 0, 0, 0)
__device__ __forceinline__ int crow(int r, int h) { return (r & 3) + 8 * (r >> 2) + 4 * h; }
__device__ __forceinline__ void attn_wave(const bf16_t* qrow, LAS const unsigned char* ks, LAS const unsigned char* vt, int lo, int hi, float sinkv, bf16_t* orow, float* ssp, int lane) {
    const int n = lane & 31, h = lane >> 5;
    bf16x8 qf[4];
#pragma unroll
    for (int kk = 0; kk < 4; ++kk) qf[kk] = *(const bf16x8*)(qrow + 16 * kk + 8 * h);
    f32x16 st[5];
#pragma unroll
    for (int kt = 0; kt < 5; ++kt) {
#pragma unroll
        for (int i = 0; i < 16; ++i) st[kt][i] = 0.f;
#pragma unroll
        for (int kk = 0; kk < 4; ++kk) { const bf16x8 kf = *(LAS const bf16x8*)(ks + (32 * kt + n) * KS_STRIDE + (16 * kk + 8 * h) * 2); st[kt] = MFMA32(kf, qf[kk], st[kt]); }
    }
    float mx = -INFINITY;
#pragma unroll
    for (int kt = 0; kt < 5; ++kt)
#pragma unroll
        for (int i = 0; i < 16; ++i) { const int jj = 32 * kt + crow(i, h); const bool ok = (jj >= lo) && (jj <= hi); const float s = ok ? st[kt][i] * 0.125f : -INFINITY; st[kt][i] = s; mx = fmaxf(mx, s); }
    mx = fmaxf(mx, __shfl_xor(mx, 32)); mx = fmaxf(mx, sinkv);
    float sum = 0.f;
#pragma unroll
    for (int kt = 0; kt < 5; ++kt)
#pragma unroll
        for (int i = 0; i < 16; ++i) { const float p = __expf(st[kt][i] - mx); st[kt][i] = p; sum += p; }
    sum += __shfl_xor(sum, 32);
    const float inv = 1.0f / (sum + __expf(sinkv - mx));
    f32x16 o[2];
#pragma unroll
    for (int i = 0; i < 16; ++i) { o[0][i] = 0.f; o[1][i] = 0.f; }
#pragma unroll
    for (int kt = 0; kt < 5; ++kt)
#pragma unroll
        for (int s = 0; s < 2; ++s) {
            u32x4 pw; pw.x = pk2(st[kt][8 * s + 0], st[kt][8 * s + 1]); pw.y = pk2(st[kt][8 * s + 2], st[kt][8 * s + 3]); pw.z = pk2(st[kt][8 * s + 4], st[kt][8 * s + 5]); pw.w = pk2(st[kt][8 * s + 6], st[kt][8 * s + 7]);
            const bf16x8 pb = __builtin_bit_cast(bf16x8, pw);
#pragma unroll
            for (int dt = 0; dt < 2; ++dt) { LAS const unsigned char* vp = vt + (32 * dt + n) * VT_STRIDE + (32 * kt + 16 * s + 4 * h) * 2;
                const u32x2 a0 = *(LAS const u32x2*)vp, a1 = *(LAS const u32x2*)(vp + 16); u32x4 aw; aw.x = a0.x; aw.y = a0.y; aw.z = a1.x; aw.w = a1.y;
                o[dt] = MFMA32(__builtin_bit_cast(bf16x8, aw), pb, o[dt]); }
        }
    float sq = 0.f;
#pragma unroll
    for (int dt = 0; dt < 2; ++dt)
#pragma unroll
        for (int ig = 0; ig < 4; ++ig) { const float v0 = o[dt][4 * ig] * inv, v1 = o[dt][4 * ig + 1] * inv, v2 = o[dt][4 * ig + 2] * inv, v3 = o[dt][4 * ig + 3] * inv;
            sq += (v0 * v0 + v1 * v1) + (v2 * v2 + v3 * v3); u32x2 w; w.x = pk2(v0, v1); w.y = pk2(v2, v3); *(u32x2*)(orow + 32 * dt + 8 * ig + 4 * h) = w; }
    sq += __shfl_xor(sq, 32);
    if (h == 0) *ssp = sq;
}
__device__ __forceinline__ void vt_scatter(LAS unsigned char* lds, int row, int c8, u32x4 vv) {
    LAS bf16_t* vb = (LAS bf16_t*)(lds + ATT_V_OFF + (8 * c8) * VT_STRIDE + row * 2);
    vb[0 * (VT_STRIDE / 2)] = (bf16_t)(vv.x & 0xffffu); vb[1 * (VT_STRIDE / 2)] = (bf16_t)(vv.x >> 16); vb[2 * (VT_STRIDE / 2)] = (bf16_t)(vv.y & 0xffffu); vb[3 * (VT_STRIDE / 2)] = (bf16_t)(vv.y >> 16);
    vb[4 * (VT_STRIDE / 2)] = (bf16_t)(vv.z & 0xffffu); vb[5 * (VT_STRIDE / 2)] = (bf16_t)(vv.z >> 16); vb[6 * (VT_STRIDE / 2)] = (bf16_t)(vv.w & 0xffffu); vb[7 * (VT_STRIDE / 2)] = (bf16_t)(vv.w >> 16);
}
__device__ __forceinline__ void phase_attention(Frame& F, int l) {
    const bf16_t* Z = F.Z; float* ss_attn = F.SS + (size_t)(4 * l + 1) * MP * 32;
    const float* sink = F.in[I_SINK] + l * 16;
    for (int unit = F.bid; unit < 256 + 2 * DECB; unit += F.G) {
        __syncthreads();
        if (unit < 256) {
            const int b = unit >> 7, nb = (unit >> 2) & 31, kvh = (unit >> 1) & 1, qh = unit & 1;
            const int t0 = 128 * (nb - 1) + 64 * qh;
            for (int ch = F.tid; ch < 192 * 8; ch += NTHR) { const int row = ch >> 3, c8 = ch & 7, pos = t0 + row;
                u32x4 kv = (u32x4){0u, 0u, 0u, 0u}, vv = kv;
                if (pos >= 0) { const bf16_t* zr = Z + (size_t)(b * SEQ + pos) * DIN + kvh * 64 + 8 * c8; kv = *(const u32x4*)(zr + ZK); vv = *(const u32x4*)(zr + ZV); }
                *(LAS u32x4*)(F.lds + row * KS_STRIDE + c8 * 16) = kv; vt_scatter(F.lds, row, c8, vv); }
            if (nb == 31 && qh == 1) {
                for (int idx = F.tid; idx < 128 * 16; idx += NTHR) { const int w = idx >> 4, c = idx & 15; const bf16_t* zr = Z + (size_t)(b * SEQ + SEQ - WIN + w) * DIN + kvh * 64 + 4 * c;
                    const u32x2 kk = *(const u32x2*)(zr + ZK), vv = *(const u32x2*)(zr + ZV); const size_t oo = ((((size_t)l * NBATCH + b) * WIN + w) * NKV + kvh) * HD + 4 * c;
                    *(f32x4*)(F.out + O_KP + oo) = (f32x4){bflo(kk.x), bfhi(kk.x), bflo(kk.y), bfhi(kk.y)}; *(f32x4*)(F.out + O_VP + oo) = (f32x4){bflo(vv.x), bfhi(vv.x), bflo(vv.y), bfhi(vv.y)}; }
            }
            __syncthreads();
            const int n = F.lane & 31, head = kvh * 8 + F.wave;
#pragma unroll 1
            for (int sb = 0; sb < 2; ++sb) { const int s = 2 * qh + sb; const int row = b * SEQ + nb * 128 + 32 * s + n;
                int lo = n + 1; if (nb == 0) lo = max(lo, 128 - 32 * s);
                attn_wave(Z + (size_t)row * DIN + ZQ + head * 64, F.lds + 32 * sb * KS_STRIDE, F.lds + ATT_V_OFF + 32 * sb * 2, lo, n + 128, sink[head], F.CAT + (size_t)row * DM + head * 64, ss_attn + (size_t)row * 32 + head, F.lane); }
        } else {
            const int u2 = unit - 256, b = u2 >> 1, kvh = u2 & 1;
            for (int ch = F.tid; ch < 160 * 8; ch += NTHR) { const int row = ch >> 3, c8 = ch & 7;
                u32x4 kv = (u32x4){0u, 0u, 0u, 0u}, vv = kv;
                if (row < 128) { const size_t ci = ((((size_t)l * DECB + b) * WIN + row) * NKV + kvh) * HD + 8 * c8;
                    const f32x4 k0 = *(const f32x4*)(F.in[I_CK] + ci), k1 = *(const f32x4*)(F.in[I_CK] + ci + 4), v0 = *(const f32x4*)(F.in[I_CV] + ci), v1 = *(const f32x4*)(F.in[I_CV] + ci + 4);
                    kv.x = pk2(k0[0], k0[1]); kv.y = pk2(k0[2], k0[3]); kv.z = pk2(k1[0], k1[1]); kv.w = pk2(k1[2], k1[3]);
                    vv.x = pk2(v0[0], v0[1]); vv.y = pk2(v0[2], v0[3]); vv.z = pk2(v1[0], v1[1]); vv.w = pk2(v1[2], v1[3]);
                    if (row >= DECS) { const size_t oo = ((((size_t)l * DECB + b) * WIN + (row - DECS)) * NKV + kvh) * HD + 8 * c8;
                        *(f32x4*)(F.out + O_KS + oo) = k0; *(f32x4*)(F.out + O_KS + oo + 4) = k1; *(f32x4*)(F.out + O_VS + oo) = v0; *(f32x4*)(F.out + O_VS + oo + 4) = v1; }
                } else if (row < 128 + DECS) { const bf16_t* zr = Z + (size_t)(MPR + DECS * b + (row - 128)) * DIN + kvh * 64 + 8 * c8; kv = *(const u32x4*)(zr + ZK); vv = *(const u32x4*)(zr + ZV);
                    const size_t oo = ((((size_t)l * DECB + b) * WIN + (row - DECS)) * NKV + kvh) * HD + 8 * c8;
                    *(f32x4*)(F.out + O_KS + oo) = (f32x4){bflo(kv.x), bfhi(kv.x), bflo(kv.y), bfhi(kv.y)}; *(f32x4*)(F.out + O_KS + oo + 4) = (f32x4){bflo(kv.z), bfhi(kv.z), bflo(kv.w), bfhi(kv.w)};
                    *(f32x4*)(F.out + O_VS + oo) = (f32x4){bflo(vv.x), bfhi(vv.x), bflo(vv.y), bfhi(vv.y)}; *(f32x4*)(F.out + O_VS + oo + 4) = (f32x4){bflo(vv.z), bfhi(vv.z), bflo(vv.w), bfhi(vv.w)}; }
                *(LAS u32x4*)(F.lds + row * KS_STRIDE + c8 * 16) = kv; vt_scatter(F.lds, row, c8, vv); }
            __syncthreads();
            if (F.wave == 0) { const int n = F.lane & 31, t = n & 3, head = kvh * 8 + (n >> 2), row = MPR + DECS * b + t;
                attn_wave(Z + (size_t)row * DIN + ZQ + head * 64, F.lds, F.lds + ATT_V_OFF, t + 1, t + 128, sink[head], F.CAT + (size_t)row * DM + head * 64, ss_attn + (size_t)row * 32 + head, F.lane); }
        }
    }
}

__device__ __forceinline__ void wave_lds_sync() { asm volatile("s_waitcnt lgkmcnt(0)" ::: "memory"); __builtin_amdgcn_wave_barrier(); asm volatile("" ::: "memory"); }
__device__ __forceinline__ void scan_load_u(const bf16_t* Z, int row0, int T, int g, LAS float* UB, int lane) {
    for (int ch = lane; ch < 2 * T; ch += 64) { const int tok = ch >> 1, hf = ch & 1; const u32x4 v = *(const u32x4*)(Z + (size_t)(row0 + tok) * DIN + ZU + 16 * g + 8 * hf);
        *(LAS f32x4*)(UB + tok * 16 + 8 * hf) = (f32x4){bflo(v.x), bfhi(v.x), bflo(v.y), bfhi(v.y)}; *(LAS f32x4*)(UB + tok * 16 + 8 * hf + 4) = (f32x4){bflo(v.z), bfhi(v.z), bflo(v.w), bfhi(v.w)}; }
}
#define SCAN_STEP(t) do { const LAS f32x4* up = (const LAS f32x4*)(UB + (t) * 16); const f32x4 u0 = up[0], u1 = up[1], u2 = up[2], u3 = up[3]; \
        float br = 0.f, bi = 0.f; \
        _Pragma("unroll") for (int c = 0; c < 4; ++c) { br += bbr[c] * u0[c]; bi += bbi[c] * u0[c]; } \
        _Pragma("unroll") for (int c = 0; c < 4; ++c) { br += bbr[4 + c] * u1[c]; bi += bbi[4 + c] * u1[c]; } \
        _Pragma("unroll") for (int c = 0; c < 4; ++c) { br += bbr[8 + c] * u2[c]; bi += bbi[8 + c] * u2[c]; } \
        _Pragma("unroll") for (int c = 0; c < 4; ++c) { br += bbr[12 + c] * u3[c]; bi += bbi[12 + c] * u3[c]; } \
        const float nr_ = ar * hr - ai * hi + br, ni_ = ar * hi + ai * hr + bi; hr = nr_; hi = ni_; } while (0)

__device__ __forceinline__ void phase_scan_a(Frame& F, int l) {
    LAS float* UB = (LAS float*)(F.lds + F.wave * SCAN_WAVE_BYTES);
    const float* sp = F.SPp + (size_t)l * SPL; const int p = F.lane;
    const int gw = F.bid * NWAVES + F.wave, NGW = F.G * NWAVES;
    for (int task = gw; task < NBATCH * NG * 31; task += NGW) {
        const int c = task % 31, bg = task / 31, g = bg % NG, b = bg / NG;
        wave_lds_sync();
        scan_load_u(F.Z, b * SEQ + c * 128, 128, g, UB, F.lane);
        float bbr[16], bbi[16];
#pragma unroll
        for (int q = 0; q < 4; ++q) { const f32x4 x = *(const f32x4*)(sp + 2 * NG * SP + (g * SP + p) * 16 + 4 * q), y = *(const f32x4*)(sp + 2 * NG * SP + NG * SP * 16 + (g * SP + p) * 16 + 4 * q);
            bbr[4 * q] = x[0]; bbr[4 * q + 1] = x[1]; bbr[4 * q + 2] = x[2]; bbr[4 * q + 3] = x[3]; bbi[4 * q] = y[0]; bbi[4 * q + 1] = y[1]; bbi[4 * q + 2] = y[2]; bbi[4 * q + 3] = y[3]; }
        const float ar = sp[g * SP + p], ai = sp[NG * SP + g * SP + p];
        float hr = 0.f, hi = 0.f;
        wave_lds_sync();
#pragma unroll 4
        for (int t = 0; t < 128; ++t) SCAN_STEP(t);
        *(float2*)(F.SC + ((size_t)(bg * 32 + c) * SP + p) * 2) = make_float2(hr, hi);
    }
}
__device__ __forceinline__ void phase_scan_c(Frame& F, int l) {
    LAS float* UB = (LAS float*)(F.lds + F.wave * SCAN_WAVE_BYTES); LAS float* HB = UB + 2048;
    const float* sp = F.SPp + (size_t)l * SPL; const int p = F.lane, ch = F.lane & 15, tq = F.lane >> 4;
    const int gw = F.bid * NWAVES + F.wave, NGW = F.G * NWAVES;
    constexpr int NPT = NBATCH * NG * 32, NST = DECB * NG;
    for (int task = gw; task < NPT + NST; task += NGW) {
        int c, g, b, row0, T; const bool prompt = task < NPT;
        if (prompt) { c = task % 32; const int bg = task / 32; g = bg % NG; b = bg / NG; row0 = b * SEQ + c * 128; T = 128; }
        else { const int t2 = task - NPT; c = 0; g = t2 % NG; b = t2 / NG; row0 = MPR + DECS * b; T = DECS; }
        wave_lds_sync();
        scan_load_u(F.Z, row0, T, g, UB, F.lane);
        float bbr[16], bbi[16];
#pragma unroll
        for (int q = 0; q < 4; ++q) { const f32x4 x = *(const f32x4*)(sp + 2 * NG * SP + (g * SP + p) * 16 + 4 * q), y = *(const f32x4*)(sp + 2 * NG * SP + NG * SP * 16 + (g * SP + p) * 16 + 4 * q);
            bbr[4 * q] = x[0]; bbr[4 * q + 1] = x[1]; bbr[4 * q + 2] = x[2]; bbr[4 * q + 3] = x[3]; bbi[4 * q] = y[0]; bbi[4 * q + 1] = y[1]; bbi[4 * q + 2] = y[2]; bbi[4 * q + 3] = y[3]; }
        const float ar = sp[g * SP + p], ai = sp[NG * SP + g * SP + p];
        float hr = 0.f, hi = 0.f;
        if (prompt) {
            float tr = ar, ti = ai;
#pragma unroll
            for (int q = 0; q < 7; ++q) { const float xr = tr * tr - ti * ti, xi = 2.f * tr * ti; tr = xr; ti = xi; }
            const float2* scp = (const float2*)F.SC + (size_t)((b * NG + g) * 32) * SP + p;
            for (int j = 0; j < c; ++j) { const float2 s = scp[(size_t)j * SP]; const float xr = tr * hr - ti * hi + s.x, xi = tr * hi + ti * hr + s.y; hr = xr; hi = xi; }
        } else { const size_t si = (((size_t)l * DECB + b) * NG + g) * SP + p; hr = F.in[I_SRE][si]; hi = F.in[I_SIM][si]; }
        float cre[16], cim[16];
        { const float* cr = F.in[I_CRE] + (((size_t)l * NG + g) * 16 + ch) * SP + 16 * tq; const float* ci = F.in[I_CIM] + (((size_t)l * NG + g) * 16 + ch) * SP + 16 * tq;
#pragma unroll
          for (int q = 0; q < 4; ++q) { const f32x4 x = *(const f32x4*)(cr + 4 * q), y = *(const f32x4*)(ci + 4 * q);
              cre[4 * q] = x[0]; cre[4 * q + 1] = x[1]; cre[4 * q + 2] = x[2]; cre[4 * q + 3] = x[3]; cim[4 * q] = y[0]; cim[4 * q + 1] = y[1]; cim[4 * q + 2] = y[2]; cim[4 * q + 3] = y[3]; } }
        const float dch = F.in[I_D][l * SW + g * 16 + ch];
        wave_lds_sync();
        for (int t0 = 0; t0 < T; t0 += 16) {
            const int nt = min(16, T - t0);
            for (int tt = 0; tt < nt; ++tt) { SCAN_STEP(t0 + tt); HB[tt * HB_STRIDE + p] = hr; HB[tt * HB_STRIDE + 64 + p] = hi; }
            wave_lds_sync();
            float ysel[4] = {0.f, 0.f, 0.f, 0.f};
#pragma unroll
            for (int tt = 0; tt < 16; ++tt) {
                if (tt < nt) { const LAS f32x4* hp = (const LAS f32x4*)(HB + tt * HB_STRIDE + 16 * tq); float y0 = 0.f, y1 = 0.f;
#pragma unroll
                    for (int q = 0; q < 4; ++q) { const f32x4 a = hp[q], bq = hp[16 + q];
                        y0 += a[0] * cre[4 * q] + a[1] * cre[4 * q + 1] + a[2] * cre[4 * q + 2] + a[3] * cre[4 * q + 3];
                        y1 += bq[0] * cim[4 * q] + bq[1] * cim[4 * q + 1] + bq[2] * cim[4 * q + 2] + bq[3] * cim[4 * q + 3]; }
                    float y = y0 - y1; y += __shfl_xor(y, 16); y += __shfl_xor(y, 32);
                    if ((tt & 3) == tq) ysel[tt >> 2] = y; } }
#pragma unroll
            for (int i = 0; i < 4; ++i) { const int tt = 4 * i + tq;
                if (tt < nt) { const float y = ysel[i] + dch * UB[(t0 + tt) * 16 + ch];
                    const float z = 0.5f * y * (1.0f + erff(y * 0.70710678118654752f));
                    F.ZS[(size_t)(row0 + t0 + tt) * SW + g * 16 + ch] = (bf16_t)f2bf(z); } }
            wave_lds_sync();
        }
        if (prompt) { if (c == 31) { const size_t oi = (((size_t)l * NBATCH + b) * NG + g) * SP + p; F.out[O_HRP + oi] = hr; F.out[O_HIP + oi] = hi; } }
        else { const size_t oi = (((size_t)l * DECB + b) * NG + g) * SP + p; F.out[O_HRS + oi] = hr; F.out[O_HIS + oi] = hi; }
    }
}
__device__ __forceinline__ void phase_final(Frame& F) {
    const int gw = F.bid * NWAVES + F.wave, NGW = F.G * NWAVES; const float* ssf = F.SS + (size_t)16 * MP * 32; const f32x4* gf = (const f32x4*)F.in[I_NFIN] + F.lane;
    for (int m = gw; m < MT; m += NGW) { float sp_ = ssf[(size_t)m * 32 + (F.lane & 31)];
#pragma unroll
        for (int o_ = 1; o_ < 32; o_ <<= 1) sp_ += __shfl_xor(sp_, o_);
        const float rs = rsqrtf(sp_ * (1.0f / DM) + EPS); const f32x4* xf = (const f32x4*)(F.XF + (size_t)m * DM) + F.lane; f32x4* o = (f32x4*)(F.out + O_YP + (size_t)m * DM) + F.lane;
#pragma unroll
        for (int j = 0; j < 8; ++j) o[64 * j] = xf[64 * j] * rs * gf[64 * j]; }
}

template <class Sched> __device__ __forceinline__ void prep_rs(const Sched& S, LAS float* tab, const float* ssp, int nq, float invn, int tid) {
    for (int i = 0; i < 8; ++i) { pg8::Unit u; if (!S.next(i, u)) break;
        if (tid < 256) { const f32x4* pp = (const f32x4*)(ssp + (size_t)(u.pm * 256 + tid) * 32); float s = 0.f;
            for (int q = 0; q < nq; ++q) { const f32x4 v = pp[q]; s += (v[0] + v[1]) + (v[2] + v[3]); }
            tab[i * 256 + tid] = rsqrtf(s * invn + EPS); } }
    __syncthreads();
}
__global__ void __launch_bounds__(NTHR, 2) mega_fwd(Params P) {
    extern __shared__ __attribute__((aligned(16))) unsigned char lds_raw[];
    cg::grid_group grid = cg::this_grid();
    const int ph_lo = P.ph_lo, ph_hi = P.ph_hi;
    const int wave_s = __builtin_amdgcn_readfirstlane((int)threadIdx.x >> 6);
#define BUILD_FRAME() \
        const CAS Params* pp = (const CAS Params*)__builtin_amdgcn_kernarg_segment_ptr(); asm volatile("" : "+s"(pp)); \
        int tid_ = wave_s * 64 + (int)__builtin_amdgcn_mbcnt_hi(~0u, __builtin_amdgcn_mbcnt_lo(~0u, 0u)); asm volatile("" : "+v"(tid_)); \
        int bid_ = blockIdx.x; asm volatile("" : "+s"(bid_)); \
        int G_ = gridDim.x; asm volatile("" : "+s"(G_)); \
        Frame F; \
        F.lds = (LAS unsigned char*)lds_raw; F.tid = tid_; F.lane = tid_ & 63; F.wave = __builtin_amdgcn_readfirstlane(tid_ >> 6); F.G = G_; F.bid = bid_; \
        F.in = pp->in; F.out = pp->out; F.ws = pp->ws; \
        unsigned char* const ws = F.ws; \
        F.XF = (float*)(ws + WS_XF); F.XB = (bf16_t*)(ws + WS_XB); F.Z = (bf16_t*)(ws + WS_Z); F.CAT = (bf16_t*)(ws + WS_CAT); F.ZS = (bf16_t*)(ws + WS_ZS); F.H = (bf16_t*)(ws + WS_H); \
        F.SS = (float*)(ws + WS_SS); F.SPp = (float*)(ws + WS_SP); F.SC = (float*)(ws + WS_SC);
    int ph = ph_lo;
    if (ph == 0) { { BUILD_FRAME(); if (PHMASK & 128) phase_prologue(F); } ++ph; __syncthreads(); }
    const int ph_end = ph_hi < N_PHASES - 1 ? ph_hi : N_PHASES - 1;
#pragma unroll 1
    for (; ph < ph_end; ++ph) {
        if (ph > ph_lo) grid.sync();
        BUILD_FRAME();
        const int l = (ph - 1) / 7, s = (ph - 1) % 7;
        const bf16_t* wl = (const bf16_t*)(ws + WS_W + (size_t)l * WL_SIZE);
        float* ssl = F.SS + (size_t)(4 * l) * MP * 32; constexpr size_t SSA = (size_t)MP * 32;
        LAS float* tab0 = (LAS float*)(F.lds + pg8::STAGE_BYTES); LAS float* tab1 = tab0 + 2048;
        if (s == 0) { if (PHMASK & 1) {
            pg8::Gemm g{F.XB, wl + WL_IN / 2, MP, DIN, DM}; pg8::StaticOrder S; S.init(MP, DIN, F.G, (int)F.bid);
            prep_rs(S, tab0, ssl, 8, 1.0f / 2048.0f, F.tid);
            pg8::EpiIn E{F.Z, DIN, tab0};
            pg8::gemm_phase<pg8::EpiIn, pg8::StaticOrder, true, true>(F.lds, g, S, E, F.tid); }
        } else if (s == 1) {
            if (PHMASK & 2) phase_attention(F, l); __syncthreads(); if (PHMASK & 512) phase_scan_a(F, l);
        } else if (s == 2) {
            if (PHMASK & 4) phase_scan_c(F, l);
        } else if (s == 3) { if (PHMASK & 8) {
            pg8::Gemm g{F.ZS, wl + WL_GLU / 2, MP, SW, SW}; pg8::StaticOrder S; S.init(MP, SW, F.G, (int)F.bid);
            pg8::EpiGlu E{F.ZS, SW, F.CAT + AW, DM, ssl + 2 * SSA};
            pg8::gemm_phase<pg8::EpiGlu, pg8::StaticOrder, true, true>(F.lds, g, S, E, F.tid); }
        } else if (s == 4) { if (PHMASK & 16) {
            pg8::Gemm g{F.CAT, wl + WL_OUT / 2, MP, DM, DM}; pg8::StaticOrder S; S.init(MP, DM, F.G, (int)F.bid);
            prep_rs(S, tab0, ssl + 1 * SSA, 4, 1.0f / 1024.0f, F.tid); prep_rs(S, tab1, ssl + 2 * SSA, 4, 1.0f / 1024.0f, F.tid);
            for (int i = F.tid; i < 2048; i += NTHR) tab0[i] = tab0[i] / tab1[i];
            __syncthreads();
            pg8::EpiRes<true> E{F.XF, F.XB, DM, ssl + 3 * SSA, tab0, tab1, AW / pg8::BK};
            pg8::gemm_phase<pg8::EpiRes<true>, pg8::StaticOrder, true, true>(F.lds, g, S, E, F.tid); }
        } else if (s == 5) { if (PHMASK & 32) {
            pg8::Gemm g{F.XB, wl + WL_GU / 2, MP, 2 * DFF, DM}; pg8::StaticOrder S; S.init(MP, 2 * DFF, F.G, (int)F.bid);
            prep_rs(S, tab0, ssl + 3 * SSA, 8, 1.0f / 2048.0f, F.tid);
            pg8::EpiGU E{F.H, DFF, tab0};
            pg8::gemm_phase<pg8::EpiGU, pg8::StaticOrder, true, true>(F.lds, g, S, E, F.tid); }
        } else { if (PHMASK & 64) {
            pg8::Gemm g{F.H, wl + WL_DN / 2, MP, DM, DFF}; pg8::StaticOrder S; S.init(MP, DM, F.G, (int)F.bid);
            pg8::EpiRes<false> E{F.XF, F.XB, DM, ssl + 4 * SSA, (LAS float*)nullptr, (LAS float*)nullptr, -1};
            pg8::gemm_phase<pg8::EpiRes<false>, pg8::StaticOrder, true, true>(F.lds, g, S, E, F.tid); }
        }
        __syncthreads();
    }
    if (ph_hi == N_PHASES) { if (ph > ph_lo) grid.sync(); BUILD_FRAME(); if (PHMASK & 256) phase_final(F); }
}

extern "C" void kernel_launch(void* const* d_in, const int* in_sizes, int n_in, void* d_out, int out_size, void* d_ws, size_t ws_size, hipStream_t stream) {
    static int grid = 0;
    if (grid == 0) {
        if (n_in != N_IN || (size_t)out_size != O_END || ws_size < WS_END) { fprintf(stderr, "kernel_launch: unexpected sizes: n_in %d out %d ws %zu (need %zu)\n", n_in, out_size, ws_size, (size_t)WS_END); grid = -1; return; }
        int dev = 0, cus = 0, per_cu = 0;
        (void)hipGetDevice(&dev); (void)hipDeviceGetAttribute(&cus, hipDeviceAttributeMultiprocessorCount, dev);
        if (hipFuncSetAttribute((const void*)mega_fwd, hipFuncAttributeMaxDynamicSharedMemorySize, LDS_BYTES) != hipSuccess) { fprintf(stderr, "kernel_launch: hipFuncSetAttribute failed\n"); grid = -1; return; }
        if (hipOccupancyMaxActiveBlocksPerMultiprocessor(&per_cu, (const void*)mega_fwd, NTHR, LDS_BYTES) != hipSuccess || per_cu < 1) { fprintf(stderr, "kernel_launch: occupancy query gave %d\n", per_cu); per_cu = 1; }
        (void)hipGetLastError();
        grid = cus * per_cu;
        fprintf(stderr, "kernel_launch: grid %d (cus %d x %d)\n", grid, cus, per_cu);
    }
    if (grid < 0) return;
    Params p{};
    for (int i = 0; i < N_IN; ++i) p.in[i] = (const float*)d_in[i];
    p.out = (float*)d_out; p.ws = (unsigned char*)d_ws;
#if MK_SINGLE
    p.ph_lo = 0; p.ph_hi = N_PHASES;
    void* args[] = {&p};
    const hipError_t e = hipLaunchCooperativeKernel((const void*)mega_fwd, dim3(grid), dim3(NTHR), args, LDS_BYTES, stream);
    if (e != hipSuccess) fprintf(stderr, "kernel_launch: cooperative launch failed: %s (grid %d)\n", hipGetErrorString(e), grid);
#else
    for (int ph = 0; ph < N_PHASES; ++ph) { p.ph_lo = ph; p.ph_hi = ph + 1; hipLaunchKernelGGL(mega_fwd, dim3(grid), dim3(NTHR), LDS_BYTES, stream, p); }
#endif
}
```

```cpp
#include <hip/hip_runtime.h>
#include <hip/hip_cooperative_groups.h>
#include <cstdio>
#include <cstdint>
namespace cg = cooperative_groups;

#define SCAN_OLD 1
#ifndef MK_SINGLE
#define MK_SINGLE 1
#endif

constexpr int DM = 2048, SEQ = 4096, NBATCH = 2, DEPTH = 4, DECB = 32, DECS = 4;
constexpr int AW = 1024, SW = 1024, HD = 64, NKV = 2, WIN = 128, NG = 64, SP = 64;
constexpr int DIN = 2304, DFF = 5632;
constexpr int MPR = NBATCH * SEQ, MSM = DECB * DECS, MT = MPR + MSM, MP = 8448;
constexpr float EPS = 1e-5f;
constexpr int ZQ = 0, ZK = 1024, ZV = 1152, ZU = 1280;

enum { I_XP = 0, I_XS, I_CK, I_CV, I_SRE, I_SIM, I_NMIX, I_WIN, I_SINK, I_ARE, I_AIM, I_LDT, I_BRE, I_BIM, I_CRE, I_CIM, I_D, I_WGLU, I_NATT, I_NSSM, I_WOUT, I_NFFN, I_WG, I_WU, I_WD, I_NFIN, N_IN };

constexpr size_t O_YP = 0, O_YS = O_YP + (size_t)MPR * DM, O_KP = O_YS + (size_t)MSM * DM, O_VP = O_KP + (size_t)DEPTH * NBATCH * WIN * 128,
                 O_HRP = O_VP + (size_t)DEPTH * NBATCH * WIN * 128, O_HIP = O_HRP + (size_t)DEPTH * NBATCH * NG * SP, O_KS = O_HIP + (size_t)DEPTH * NBATCH * NG * SP,
                 O_VS = O_KS + (size_t)DEPTH * DECB * WIN * 128, O_HRS = O_VS + (size_t)DEPTH * DECB * WIN * 128, O_HIS = O_HRS + (size_t)DEPTH * DECB * NG * SP,
                 O_END = O_HIS + (size_t)DEPTH * DECB * NG * SP;

constexpr size_t al256(size_t x) { return (x + 255) & ~(size_t)255; }
constexpr size_t WB_IN = (size_t)DIN * DM * 2, WB_GLU = (size_t)SW * SW * 2, WB_OUT = (size_t)DM * DM * 2, WB_GU = (size_t)2 * DFF * DM * 2, WB_DN = (size_t)DM * DFF * 2;
constexpr size_t WL_IN = 0, WL_GLU = WL_IN + WB_IN, WL_OUT = WL_GLU + WB_GLU, WL_GU = WL_OUT + WB_OUT, WL_DN = WL_GU + WB_GU, WL_SIZE = WL_DN + WB_DN;
constexpr size_t WS_W = 0;
constexpr size_t WS_XF = al256(WS_W + DEPTH * WL_SIZE);
constexpr size_t WS_XB = al256(WS_XF + (size_t)MP * DM * 4);
constexpr size_t WS_Z = al256(WS_XB + (size_t)MP * DM * 2);
constexpr size_t WS_CAT = al256(WS_Z + (size_t)MP * DIN * 2);
constexpr size_t WS_ZS = al256(WS_CAT + (size_t)MP * DM * 2);
constexpr size_t WS_H = al256(WS_ZS + (size_t)MP * SW * 2);
constexpr size_t WS_SS = al256(WS_H + (size_t)MP * DFF * 2);
constexpr int NSS = 17;
constexpr size_t WS_SP = al256(WS_SS + (size_t)NSS * MP * 32 * 4);
constexpr size_t SPL = (size_t)(2 * NG * SP + 2 * NG * SP * 16);
constexpr size_t WS_SC = al256(WS_SP + DEPTH * SPL * 4);
constexpr size_t WS_CTL = al256(WS_SC + (size_t)NBATCH * NG * 32 * SP * 8), CTL_BYTES = 16384;
constexpr size_t SPLO = (size_t)(2 * NG * SP + 2 * NG * SP * 16);
constexpr size_t WS_SPO = WS_CTL + CTL_BYTES;
constexpr size_t WS_END = WS_SPO + DEPTH * SPLO * 4;

#define LAS __attribute__((address_space(3)))
typedef unsigned short bf16_t;
typedef short bf16x8 __attribute__((ext_vector_type(8)));
typedef short s16x4 __attribute__((ext_vector_type(4)));
typedef float f32x4 __attribute__((ext_vector_type(4)));
typedef float f32x16 __attribute__((ext_vector_type(16)));
typedef unsigned u32x4 __attribute__((ext_vector_type(4)));
typedef unsigned u32x2 __attribute__((ext_vector_type(2)));

__device__ __forceinline__ unsigned f2bf(float f) { unsigned u = __builtin_bit_cast(unsigned, f); return (u + 0x7fffu + ((u >> 16) & 1u)) >> 16; }
__device__ __forceinline__ unsigned pk2(float lo, float hi) { return f2bf(lo) | (f2bf(hi) << 16); }
__device__ __forceinline__ float bflo(unsigned w) { return __builtin_bit_cast(float, w << 16); }
__device__ __forceinline__ float bfhi(unsigned w) { return __builtin_bit_cast(float, w & 0xffff0000u); }
__device__ __forceinline__ float bf2f(bf16_t b) { return __builtin_bit_cast(float, (unsigned)b << 16); }
__device__ __forceinline__ float wave_sum(float v) {
#pragma unroll
    for (int o = 1; o < 64; o <<= 1) v += __shfl_xor(v, o);
    return v;
}
namespace pg8 {
#define PG8_LAS __attribute__((address_space(3)))
typedef unsigned short bf16_t;
typedef short bf16x8 __attribute__((ext_vector_type(8)));
typedef float f32x4 __attribute__((ext_vector_type(4)));
typedef unsigned u32x4 __attribute__((ext_vector_type(4)));
constexpr int BM = 256, BK = 64, HALF = 128, HTB = HALF * BK * 2  , STAGE_BYTES = 8 * HTB, NXCD = 8, WGM = 8;

__host__ __device__ __forceinline__ int lds_byte(int r, int c) { const int st = (r >> 4) * 2 + (c >> 5), rr = r & 15, cc = c & 31, ob = rr * 64 + cc * 2; return st * 1024 + (ob ^ (((ob >> 9) & 1) << 5)); }
__host__ __device__ __forceinline__ void stage_rc(int b, int& R, int& C) { const int st = b / 1024, sb = b % 1024, swz = sb ^ (((sb >> 9) & 1) << 5); R = (st >> 1) * 16 + swz / 64; C = (st & 1) * 32 + (swz % 64) / 2; }
__host__ __device__ __forceinline__ int perm32(int rho) { const int n = rho >> 4, i = rho & 15; return 8 * (i >> 2) + 4 * n + (i & 3); }

struct Unit { int pm, pn; };
struct Gemm { const bf16_t* A; const bf16_t* Bt; int M, N, K; };

struct StaticOrder {
    int nM, nN, nwg, G, c;
    __host__ __device__ void init(int M, int N, int G_, int c_) { nM = M / BM; nN = N / BM; nwg = nM * nN; G = G_; c = c_; }
    __host__ __device__ bool next(int i, Unit& u) const {
        const long L = (long)i * G + c; if (L >= nwg) return false;
        int wgid = (int)L; { const int q = nwg / NXCD, r = nwg % NXCD, xcd = wgid % NXCD, off = wgid / NXCD; wgid = (xcd < r ? xcd * (q + 1) : r * (q + 1) + (xcd - r) * q) + off; }
        const int nig = WGM * nN, gid = wgid / nig, fm = gid * WGM, gsz = (nM - fm) < WGM ? (nM - fm) : WGM;
        u.pm = fm + ((wgid % nig) % gsz); u.pn = (wgid % nig) / gsz; return true;
    }
    __device__ __forceinline__ void a_ready(const Unit&) const {}
    __device__ __forceinline__ void done(const Unit&) const {}
};

__device__ __forceinline__ unsigned cvt_pk_bf16(float lo, float hi) { unsigned r; asm volatile("v_cvt_pk_bf16_f32 %0, %1, %2" : "=v"(r) : "v"(lo), "v"(hi)); return r; }
typedef float f32x2 __attribute__((ext_vector_type(2)));
__device__ __forceinline__ float rs_of(const float* ss, int r, float invn) { return rsqrtf(ss[r] * invn + 1e-5f); }

struct EpiIn {
    static constexpr bool PERM = true, AFTER_DRAIN = false, MIDK = false;
    bf16_t* O; int ldc; const LAS float* rst;
    __device__ __forceinline__ void operator()(const f32x4 (&acc)[2][2][4][2], const Unit& u, int ui, int wr, int wc, int fr, int fq) const {
        const int row0 = u.pm * BM + wr * 64 + fr, col0 = u.pn * BM + wc * 32 + 8 * fq, lr0 = (ui & 7) * 256 + wr * 64 + fr;
#pragma unroll
        for (int ai = 0; ai < 2; ++ai)
#pragma unroll
            for (int m = 0; m < 4; ++m) { const int r = row0 + ai * HALF + m * 16; const float rs = rst[lr0 + ai * HALF + m * 16]; bf16_t* rowp = O + (size_t)r * ldc + col0;
#pragma unroll
                for (int bj = 0; bj < 2; ++bj) { const f32x4 v0 = acc[ai][bj][m][0] * rs, v1 = acc[ai][bj][m][1] * rs;
                    u32x4 w; w.x = cvt_pk_bf16(v0[0], v0[1]); w.y = cvt_pk_bf16(v0[2], v0[3]); w.z = cvt_pk_bf16(v1[0], v1[1]); w.w = cvt_pk_bf16(v1[2], v1[3]);
                    *(u32x4*)(rowp + bj * HALF) = w; } }
    }
};
struct EpiGlu {
    static constexpr bool PERM = true, AFTER_DRAIN = false, MIDK = false;
    const bf16_t* ZS; int ldz; bf16_t* O; int ldc; float* ssq;
    __device__ __forceinline__ void operator()(const f32x4 (&acc)[2][2][4][2], const Unit& u, int ui, int wr, int wc, int fr, int fq) const {
        const int row0 = u.pm * BM + wr * 64 + fr, col0 = u.pn * BM + wc * 32 + 8 * fq;
#pragma unroll
        for (int ai = 0; ai < 2; ++ai)
#pragma unroll
            for (int m = 0; m < 4; ++m) { const int r = row0 + ai * HALF + m * 16; float sq = 0.f;
#pragma unroll
                for (int bj = 0; bj < 2; ++bj) { const u32x4 zv = *(const u32x4*)(ZS + (size_t)r * ldz + col0 + bj * HALF);
                    const f32x4 a0 = acc[ai][bj][m][0], a1 = acc[ai][bj][m][1];
                    float z[8] = {bflo(zv.x), bfhi(zv.x), bflo(zv.y), bfhi(zv.y), bflo(zv.z), bfhi(zv.z), bflo(zv.w), bfhi(zv.w)};
                    float g[8] = {a0[0], a0[1], a0[2], a0[3], a1[0], a1[1], a1[2], a1[3]};
#pragma unroll
                    for (int e = 0; e < 8; ++e) { z[e] = z[e] * __builtin_amdgcn_rcpf(1.0f + __expf(-g[e])); sq += z[e] * z[e]; }
                    u32x4 w; w.x = cvt_pk_bf16(z[0], z[1]); w.y = cvt_pk_bf16(z[2], z[3]); w.z = cvt_pk_bf16(z[4], z[5]); w.w = cvt_pk_bf16(z[6], z[7]);
                    *(u32x4*)(O + (size_t)r * ldc + col0 + bj * HALF) = w; }
                sq += __shfl_xor(sq, 16); sq += __shfl_xor(sq, 32);
                if (fq == 0) ssq[(size_t)r * 32 + u.pn * 4 + wc] = sq; }
    }
};
template <bool MID> struct EpiRes {
    static constexpr bool PERM = false, AFTER_DRAIN = false, MIDK = MID;
    float* XF; bf16_t* XB; int ldc; float* ssq; const LAS float* rt; const LAS float* rst; int tmid;
    __device__ __forceinline__ void mid(f32x4 (&acc)[2][2][4][2], int ui, int wr, int fr) const {
        const int row0 = (ui & 7) * 256 + wr * 64 + fr;
#pragma unroll
        for (int ai = 0; ai < 2; ++ai)
#pragma unroll
            for (int m = 0; m < 4; ++m) { const int r = row0 + ai * HALF + m * 16; const float f = rt[r];
#pragma unroll
                for (int bj = 0; bj < 2; ++bj)
#pragma unroll
                    for (int n = 0; n < 2; ++n) acc[ai][bj][m][n] = acc[ai][bj][m][n] * f; }
    }
    __device__ __forceinline__ void operator()(const f32x4 (&acc)[2][2][4][2], const Unit& u, int ui, int wr, int wc, int fr, int fq) const {
        const int row0 = u.pm * BM + wr * 64 + fr, col0 = u.pn * BM + wc * 32 + 4 * fq, lr0 = (ui & 7) * 256 + wr * 64 + fr;
#pragma unroll
        for (int ai = 0; ai < 2; ++ai)
#pragma unroll
            for (int m = 0; m < 4; ++m) { const int r = row0 + ai * HALF + m * 16; const float sc = MID ? rst[lr0 + ai * HALF + m * 16] : 1.0f; float sq = 0.f;
                const size_t off = (size_t)r * ldc + col0;
#pragma unroll
                for (int bj = 0; bj < 2; ++bj)
#pragma unroll
                    for (int n = 0; n < 2; ++n) { const size_t o = off + bj * HALF + n * 16; const f32x4 x = *(const f32x4*)(XF + o) + acc[ai][bj][m][n] * sc;
                        *(f32x4*)(XF + o) = x; sq += (x[0] * x[0] + x[1] * x[1]) + (x[2] * x[2] + x[3] * x[3]);
                        u32x2 w; w.x = cvt_pk_bf16(x[0], x[1]); w.y = cvt_pk_bf16(x[2], x[3]); *(u32x2*)(XB + o) = w; }
                sq += __shfl_xor(sq, 16); sq += __shfl_xor(sq, 32);
                if (fq == 0) ssq[(size_t)r * 32 + u.pn * 4 + wc] = sq; }
    }
};
struct EpiGU {
    static constexpr bool PERM = true, AFTER_DRAIN = false, MIDK = false;
    bf16_t* O; int ldc; const LAS float* rst;
    __device__ __forceinline__ void operator()(const f32x4 (&acc)[2][2][4][2], const Unit& u, int ui, int wr, int wc, int fr, int fq) const {
        const int row0 = u.pm * BM + wr * 64 + fr, col0 = u.pn * HALF + wc * 32 + 8 * fq, lr0 = (ui & 7) * 256 + wr * 64 + fr;
#pragma unroll
        for (int ai = 0; ai < 2; ++ai)
#pragma unroll
            for (int m = 0; m < 4; ++m) { const int r = row0 + ai * HALF + m * 16; const float rs = rst[lr0 + ai * HALF + m * 16];
                float h[8];
#pragma unroll
                for (int n = 0; n < 2; ++n)
#pragma unroll
                    for (int e = 0; e < 4; ++e) { const float g = acc[ai][0][m][n][e] * rs, v = acc[ai][1][m][n][e] * rs; h[n * 4 + e] = (g * __builtin_amdgcn_rcpf(1.0f + __expf(-g))) * v; }
                u32x4 w; w.x = cvt_pk_bf16(h[0], h[1]); w.y = cvt_pk_bf16(h[2], h[3]); w.z = cvt_pk_bf16(h[4], h[5]); w.w = cvt_pk_bf16(h[6], h[7]);
                *(u32x4*)(O + (size_t)r * ldc + col0) = w; }
    }
};
template <class Epi, class Sched, bool ALIGN_EPI = false, bool SP2 = false>
__device__ __forceinline__ void gemm_phase(PG8_LAS unsigned char* lds, const Gemm g, const Sched& S, const Epi& E, const int tid) {
    const int wid = __builtin_amdgcn_readfirstlane(tid >> 6), lane = tid & 63, wr = wid >> 2, wc = wid & 3, fr = lane & 15, fq = lane >> 4;
    const int K = g.K, nt = K / BK;
    unsigned voffA[2], voffB[2];
#pragma unroll
    for (int i = 0; i < 2; ++i) { int R, C; stage_rc(tid * 16 + i * 8192, R, C); const int Rb = Epi::PERM ? ((R & ~31) + perm32(R & 31)) : R;
        voffA[i] = (unsigned)(R * K + C) * 2u; voffB[i] = (unsigned)(Rb * K + C) * 2u; }
    const size_t kstep = (size_t)(BK * 2);
    const size_t hstep = (size_t)HALF * K * 2;
    const size_t tstep = 2 * hstep;
    const unsigned ldsw = (unsigned)wid * 1024u;
    const int aoff = lds_byte(wr * 64 + fr, fq * 8), boff = lds_byte(wc * 32 + fr, fq * 8);
#define PG8_SA(b, h) (((b) * 2 + (h)) * HTB)
#define PG8_SB(b, h) ((4 + (b) * 2 + (h)) * HTB)
#define PG8_STAGE(bufoff, gbase, voff) do { _Pragma("unroll") for (int _i = 0; _i < 2; ++_i) \
        __builtin_amdgcn_global_load_lds((const unsigned*)((const char*)(gbase) + (voff)[_i]), (PG8_LAS unsigned*)(lds + (bufoff) + ldsw + _i * 8192), 16, 0, 0); } while (0)
#define PG8_LDA(dst, b, h) do { _Pragma("unroll") for (int m = 0; m < 4; ++m) _Pragma("unroll") for (int k = 0; k < 2; ++k) dst[m][k] = *(const PG8_LAS bf16x8*)(lds + PG8_SA(b, h) + aoff + m * 2048 + k * 1024); } while (0)
#define PG8_LDB(dst, b, h) do { _Pragma("unroll") for (int n = 0; n < 2; ++n) _Pragma("unroll") for (int k = 0; k < 2; ++k) dst[n][k] = *(const PG8_LAS bf16x8*)(lds + PG8_SB(b, h) + boff + n * 2048 + k * 1024); } while (0)
#define PG8_MMA(ai, bj, At, Bt) do { __builtin_amdgcn_s_setprio(1); _Pragma("unroll") for (int m = 0; m < 4; ++m) _Pragma("unroll") for (int n = 0; n < 2; ++n) _Pragma("unroll") for (int k = 0; k < 2; ++k) \
        acc[ai][bj][m][n] = __builtin_amdgcn_mfma_f32_16x16x32_bf16(Bt[n][k], At[m][k], acc[ai][bj][m][n], 0, 0, 0); __builtin_amdgcn_s_setprio(0); } while (0)
#define PG8_WAIT_V(n) asm volatile("s_waitcnt vmcnt(" #n ")" ::: "memory")
#define PG8_WAIT_L(n) asm volatile("s_waitcnt lgkmcnt(" #n ")" ::: "memory")
#define PG8_BAR __builtin_amdgcn_s_barrier()
#define PG8_SCHED __builtin_amdgcn_sched_barrier(0)
    Unit cur, nxt; int ui = 0;
    if (!S.next(0, cur)) return;
    f32x4 acc[2][2][4][2];
#pragma unroll
    for (int a = 0; a < 2; ++a)
#pragma unroll
        for (int b = 0; b < 2; ++b)
#pragma unroll
            for (int m = 0; m < 4; ++m)
#pragma unroll
                for (int n = 0; n < 2; ++n) acc[a][b][m][n] = (f32x4){0.f, 0.f, 0.f, 0.f};
    bf16x8 At[4][2], B0[2][2], B1[2][2];
    const char* cA = (const char*)g.A + (size_t)cur.pm * tstep; const char* cB = (const char*)g.Bt + (size_t)cur.pn * tstep;
    S.a_ready(cur);
    if constexpr (SP2) {
        PG8_STAGE(PG8_SB(0, 0), cB, voffB); PG8_STAGE(PG8_SB(0, 1), cB + hstep, voffB); PG8_STAGE(PG8_SA(0, 0), cA, voffA); PG8_STAGE(PG8_SA(0, 1), cA + hstep, voffA);
        if (wr == 1) PG8_BAR;
        PG8_WAIT_V(2); PG8_BAR;
        PG8_STAGE(PG8_SB(1, 0), cB + kstep, voffB); PG8_STAGE(PG8_SA(1, 0), cA + kstep, voffA); PG8_STAGE(PG8_SB(1, 1), cB + hstep + kstep, voffB);
        PG8_WAIT_V(6); PG8_BAR;
    } else {
        PG8_STAGE(PG8_SB(0, 0), cB, voffB); PG8_STAGE(PG8_SA(0, 0), cA, voffA); PG8_STAGE(PG8_SB(0, 1), cB + hstep, voffB); PG8_STAGE(PG8_SA(0, 1), cA + hstep, voffA);
        if (wr == 1) PG8_BAR;
        PG8_WAIT_V(4); PG8_BAR;
        PG8_STAGE(PG8_SB(1, 0), cB + kstep, voffB); PG8_STAGE(PG8_SA(1, 0), cA + kstep, voffA); PG8_STAGE(PG8_SB(1, 1), cB + hstep + kstep, voffB);
        PG8_WAIT_V(6); PG8_BAR;
    }
    for (;;) {
        const bool has_next = S.next(ui + 1, nxt);
        const char* nA = has_next ? (const char*)g.A + (size_t)nxt.pm * tstep : cA; const char* nB = has_next ? (const char*)g.Bt + (size_t)nxt.pn * tstep : cB;
        for (int t = 0; t < nt; t += 2) {
            const bool last = (t == nt - 2);
            const char* a1 = cA + (size_t)(t + 1) * kstep;
            const char* a2 = last ? nA : cA + (size_t)(t + 2) * kstep; const char* b2 = last ? nB : cB + (size_t)(t + 2) * kstep;
            const char* a3 = a2 + kstep; const char* b3 = b2 + kstep;
            if (last && has_next) S.a_ready(nxt);
            if constexpr (Epi::MIDK) { if (t == E.tmid) E.mid(acc, ui, wr, fr); }
            if constexpr (SP2) {
            PG8_LDB(B0, 0, 0); PG8_LDB(B1, 0, 1); PG8_SCHED; PG8_LDA(At, 0, 0); PG8_STAGE(PG8_SA(1, 1), a1 + hstep, voffA);
            PG8_WAIT_V(8); PG8_WAIT_L(0); PG8_BAR; PG8_MMA(0, 0, At, B0); PG8_MMA(0, 1, At, B1); PG8_BAR; PG8_SCHED;
            PG8_LDA(At, 0, 1); PG8_STAGE(PG8_SB(0, 0), b2, voffB); PG8_STAGE(PG8_SB(0, 1), b2 + hstep, voffB); PG8_STAGE(PG8_SA(0, 0), a2, voffA);
            PG8_WAIT_V(8); PG8_WAIT_L(0); PG8_BAR; PG8_MMA(1, 0, At, B0); PG8_MMA(1, 1, At, B1); PG8_BAR; PG8_SCHED;
            PG8_LDB(B0, 1, 0); PG8_LDB(B1, 1, 1); PG8_SCHED; PG8_LDA(At, 1, 0); PG8_STAGE(PG8_SA(0, 1), a2 + hstep, voffA);
            PG8_WAIT_V(8); PG8_WAIT_L(0); PG8_BAR; PG8_MMA(0, 0, At, B0); PG8_MMA(0, 1, At, B1); PG8_BAR; PG8_SCHED;
            PG8_LDA(At, 1, 1); PG8_STAGE(PG8_SB(1, 0), b3, voffB); PG8_STAGE(PG8_SB(1, 1), b3 + hstep, voffB); PG8_STAGE(PG8_SA(1, 0), a3, voffA);
            PG8_WAIT_V(8); PG8_WAIT_L(0); PG8_BAR; PG8_MMA(1, 0, At, B0); PG8_MMA(1, 1, At, B1); PG8_BAR; PG8_SCHED;
            } else {
            PG8_LDB(B0, 0, 0); PG8_SCHED; PG8_LDA(At, 0, 0); PG8_STAGE(PG8_SA(1, 1), a1 + hstep, voffA);
            PG8_WAIT_L(8); PG8_BAR; PG8_WAIT_L(0); PG8_MMA(0, 0, At, B0); PG8_BAR; PG8_SCHED;
            PG8_LDB(B1, 0, 1); PG8_STAGE(PG8_SB(0, 0), b2, voffB);
            PG8_BAR; PG8_WAIT_L(0); PG8_MMA(0, 1, At, B1); PG8_BAR;
            PG8_LDA(At, 0, 1); PG8_STAGE(PG8_SA(0, 0), a2, voffA);
            PG8_BAR; PG8_WAIT_L(0); PG8_MMA(1, 0, At, B0); PG8_BAR; PG8_SCHED;
            PG8_STAGE(PG8_SB(0, 1), b2 + hstep, voffB);
            PG8_WAIT_V(6); PG8_BAR; PG8_MMA(1, 1, At, B1); PG8_BAR;
            PG8_LDB(B0, 1, 0); PG8_SCHED; PG8_LDA(At, 1, 0); PG8_STAGE(PG8_SA(0, 1), a2 + hstep, voffA);
            PG8_WAIT_L(8); PG8_BAR; PG8_WAIT_L(0); PG8_MMA(0, 0, At, B0); PG8_BAR; PG8_SCHED;
            PG8_LDB(B1, 1, 1); PG8_STAGE(PG8_SB(1, 0), b3, voffB);
            PG8_BAR; PG8_WAIT_L(0); PG8_MMA(0, 1, At, B1); PG8_BAR;
            PG8_LDA(At, 1, 1); PG8_STAGE(PG8_SA(1, 0), a3, voffA);
            PG8_BAR; PG8_WAIT_L(0); PG8_MMA(1, 0, At, B0); PG8_BAR; PG8_SCHED;
            PG8_STAGE(PG8_SB(1, 1), b3 + hstep, voffB);
            PG8_WAIT_V(6); PG8_BAR; PG8_MMA(1, 1, At, B1); PG8_BAR;
            }
        }
        if constexpr (ALIGN_EPI) { if (wr == 0) PG8_BAR; }
        if constexpr (!Epi::AFTER_DRAIN) { E(acc, cur, ui, wr, wc, fr, fq); S.done(cur); }
        if (!has_next) break;
#pragma unroll
        for (int a = 0; a < 2; ++a)
#pragma unroll
            for (int b = 0; b < 2; ++b)
#pragma unroll
                for (int m = 0; m < 4; ++m)
#pragma unroll
                    for (int n = 0; n < 2; ++n) acc[a][b][m][n] = (f32x4){0.f, 0.f, 0.f, 0.f};
        cur = nxt; cA = nA; cB = nB; ++ui;
        if constexpr (ALIGN_EPI) { if (wr == 1) PG8_BAR; }
    }
    PG8_WAIT_V(0);
    if constexpr (!ALIGN_EPI) { if (wr == 0) PG8_BAR; }
    PG8_BAR;
    if constexpr (Epi::AFTER_DRAIN) { E.fused(acc, cur, wr, wc, fr, fq, lds, wid, lane); S.done(cur); }
#undef PG8_SA
#undef PG8_SB
#undef PG8_STAGE
#undef PG8_LDA
#undef PG8_LDB
#undef PG8_MMA
#undef PG8_WAIT_V
#undef PG8_WAIT_L
#undef PG8_BAR
#undef PG8_SCHED
}
}

#ifndef PRO_LAYERS
#define PRO_LAYERS 1
#endif
#ifndef QUOTA_S0
#define QUOTA_S0 4
#define QUOTA_S3 2
#define QUOTA_S5 4
#endif
#ifdef CVT_CPP
#define CVT_HH(a, b) pk2((a), (b))
#else
#define CVT_HH(a, b) pg8::cvt_pk_bf16((a), (b))
#endif
#ifndef CHK_WHICH
#define CHK_WHICH 2
#endif
#ifdef VM_STRICT
#define VMW0() asm volatile("s_waitcnt vmcnt(0)" ::: "memory")
#define VMW0V(a, b) asm volatile("s_waitcnt vmcnt(0)" : "+v"(a), "+v"(b) :: "memory")
#else
#define VMW0()
#define VMW0V(a, b)
#endif
#ifndef CHK_SAME_IN
#define CHK_SAME_IN 0
#endif
#ifndef REP_MASK
#define REP_MASK 0
#endif
#ifndef PHMASK
#define PHMASK 1023
#endif
constexpr int NWAVES = 8, NTHR = 512;
constexpr int LDS_BYTES = 147456 + 256, MISC_OFF = 147456;
constexpr int SCAN_WAVE_BYTES = 17408, HB_STRIDE = 132;
constexpr int KS_STRIDE = 144, VT_STRIDE = 400, ATT_V_OFF = 192 * KS_STRIDE;
constexpr int N_PHASES = 2 + 7 * DEPTH;

#define CAS __attribute__((address_space(4)))
typedef const float* cfp;
struct Params { const float* in[N_IN]; float* out; unsigned char* ws; int ph_lo, ph_hi; };

struct Frame {
    LAS unsigned char* lds; int tid, lane, wave, G, bid;
    const CAS cfp* in; float* out; unsigned char* ws;
    float* XF; bf16_t* XB; bf16_t* Z; bf16_t* CAT; bf16_t* ZS; bf16_t* H; float* SS; float* SPp; float* SC; float* SPo;
};
#define LDS_WAIT() asm volatile("s_waitcnt lgkmcnt(0)" ::: "memory")

__device__ __forceinline__ void p0_transpose_item(const float* W, int K, int N, bf16_t* WT, int item, const float* g1, const float* g2, int split, int mode, LAS float* scr, int lane) {
    const int nblk = N >> 6, kb = item / nblk, nb = item - kb * nblk, k0 = 64 * kb, n0 = 64 * nb;
    const int rr = lane >> 4, cc = (lane & 15) * 4;
    f32x4 v[16];
#pragma unroll
    for (int i = 0; i < 16; ++i) v[i] = __builtin_nontemporal_load((const f32x4*)(W + (size_t)(k0 + 4 * i + rr) * N + n0 + cc));
#pragma unroll
    for (int i = 0; i < 16; ++i) { const int k = k0 + 4 * i + rr; const float g = g1 ? ((k < split) ? g1[k] : g2[k - split]) : 1.0f;
        LAS float* d = scr + (4 * i + rr) * 65 + cc; d[0] = v[i][0] * g; d[1] = v[i][1] * g; d[2] = v[i][2] * g; d[3] = v[i][3] * g; }
    LDS_WAIT();
    const int c = lane & 7;
#pragma unroll
    for (int j = 0; j < 8; ++j) { const int n = (lane >> 3) + 8 * j; const LAS float* s = scr + (8 * c) * 65 + n;
        u32x4 o; o.x = pg8::cvt_pk_bf16(s[0 * 65], s[1 * 65]); o.y = pg8::cvt_pk_bf16(s[2 * 65], s[3 * 65]); o.z = pg8::cvt_pk_bf16(s[4 * 65], s[5 * 65]); o.w = pg8::cvt_pk_bf16(s[6 * 65], s[7 * 65]);
        const int nn = n0 + n; const int drow = (mode == 0) ? nn : (((nn >> 7) << 8) + (nn & 127) + (mode == 2 ? 128 : 0));
        *(u32x4*)(WT + (size_t)drow * K + k0 + 8 * c) = o; }
    LDS_WAIT();
}
constexpr int IT_IN = (DM / 64) * (DIN / 64), IT_GLU = (SW / 64) * (SW / 64), IT_OUT = (DM / 64) * (DM / 64), IT_G = (DM / 64) * (DFF / 64), IT_D = (DFF / 64) * (DM / 64);
constexpr int IT_L = IT_IN + IT_GLU + IT_OUT + 2 * IT_G + IT_D;
__device__ __forceinline__ void convert_item(Frame& F, int l, int r) {
    LAS float* scr = (LAS float*)(F.lds + F.wave * 16640);
    bf16_t* wl = (bf16_t*)(F.ws + WS_W + (size_t)l * WL_SIZE);
    const float* W; const float* g1 = nullptr; const float* g2 = nullptr; bf16_t* WT; int K, N, split = 0, mode = 0;
    if (r < IT_IN) { W = F.in[I_WIN] + (size_t)l * DM * DIN; K = DM; N = DIN; WT = wl + WL_IN / 2; g1 = F.in[I_NMIX] + l * DM; split = DM; }
    else if ((r -= IT_IN) < IT_GLU) { W = F.in[I_WGLU] + (size_t)l * SW * SW; K = SW; N = SW; WT = wl + WL_GLU / 2; }
    else if ((r -= IT_GLU) < IT_OUT) { W = F.in[I_WOUT] + (size_t)l * DM * DM; K = DM; N = DM; WT = wl + WL_OUT / 2; g1 = F.in[I_NATT] + l * AW; g2 = F.in[I_NSSM] + l * SW; split = AW; }
    else if ((r -= IT_OUT) < IT_G) { W = F.in[I_WG] + (size_t)l * DM * DFF; K = DM; N = DFF; WT = wl + WL_GU / 2; g1 = F.in[I_NFFN] + l * DM; split = DM; mode = 1; }
    else if ((r -= IT_G) < IT_G) { W = F.in[I_WU] + (size_t)l * DM * DFF; K = DM; N = DFF; WT = wl + WL_GU / 2; g1 = F.in[I_NFFN] + l * DM; split = DM; mode = 2; }
    else { r -= IT_G; W = F.in[I_WD] + (size_t)l * DFF * DM; K = DFF; N = DM; WT = wl + WL_DN / 2; }
    p0_transpose_item(W, K, N, WT, r, g1, g2, split, mode, scr, F.lane);
}
__device__ __forceinline__ void convert_weights(Frame& F, int l_lo, int l_hi, int gw, int NGW) {
#pragma unroll 1
    for (int it = l_lo * IT_L + gw; it < l_hi * IT_L; it += NGW) convert_item(F, it / IT_L, it % IT_L);
}
__device__ __forceinline__ void convert_steal(Frame& F, int l, int quota) {
    if (l < PRO_LAYERS || l >= DEPTH) return;
    unsigned* ctr = (unsigned*)(F.ws + WS_CTL) + 3584 + 64 * l;
#pragma unroll 1
    for (int q = 0; q < quota; ++q) {
        unsigned it = 0; if (F.lane == 0) it = __hip_atomic_fetch_add(ctr, 1u, __ATOMIC_RELAXED, __HIP_MEMORY_SCOPE_AGENT);
        it = (unsigned)__builtin_amdgcn_readfirstlane((int)it);
        if (it >= (unsigned)IT_L) break;
        convert_item(F, l, (int)it);
    }
}
__device__ __forceinline__ void phase_prologue(Frame& F) {
    const int gw = F.bid * NWAVES + F.wave, NGW = F.G * NWAVES;
#ifdef NAN_POISON
    { const size_t t0_ = (size_t)F.bid * NTHR + F.tid, nt_ = (size_t)F.G * NTHR; const u32x4 nanv = (u32x4){0xffffffffu, 0xffffffffu, 0xffffffffu, 0xffffffffu};
      if (NAN_POISON & 1) for (size_t i = t0_; i < (WS_CAT - WS_Z) / 16; i += nt_) ((u32x4*)(F.ws + WS_Z))[i] = nanv;
      if (NAN_POISON & 2) for (size_t i = t0_; i < (WS_ZS - WS_CAT) / 16; i += nt_) ((u32x4*)(F.ws + WS_CAT))[i] = nanv;
      if (NAN_POISON & 4) for (size_t i = t0_; i < (WS_H - WS_ZS) / 16; i += nt_) ((u32x4*)(F.ws + WS_ZS))[i] = nanv;
      if (NAN_POISON & 8) for (size_t i = t0_; i < (WS_SS - WS_H) / 16; i += nt_) ((u32x4*)(F.ws + WS_H))[i] = nanv;
      if (NAN_POISON & 16) for (size_t i = t0_; i < (WS_CTL - WS_SC) / 16; i += nt_) ((u32x4*)(F.ws + WS_SC))[i] = nanv;
      if (NAN_POISON & 32) for (size_t i = t0_; i < ((size_t)(NSS - 1) * MP * 32 * 4) / 16; i += nt_) ((u32x4*)(F.ws + WS_SS + (size_t)MP * 32 * 4))[i] = nanv; }
#endif
    convert_weights(F, 0, PRO_LAYERS, gw, NGW);
    for (int m = gw; m < MP; m += NGW) {
        f32x4* xf = (f32x4*)(F.XF + (size_t)m * DM) + F.lane; u32x2* xb = (u32x2*)(F.XB + (size_t)m * DM) + F.lane;
        if (m < MT) {
            const f32x4* src = (const f32x4*)(m < MPR ? F.in[I_XP] + (size_t)m * DM : F.in[I_XS] + (size_t)(m - MPR) * DM) + F.lane;
            float s = 0.f;
#pragma unroll
            for (int j = 0; j < 8; ++j) { const f32x4 v = src[64 * j]; s += (v[0] * v[0] + v[1] * v[1]) + (v[2] * v[2] + v[3] * v[3]); xf[64 * j] = v; u32x2 w; w.x = pg8::cvt_pk_bf16(v[0], v[1]); w.y = pg8::cvt_pk_bf16(v[2], v[3]); xb[64 * j] = w; }
            s = wave_sum(s); if (F.lane < 32) F.SS[(size_t)m * 32 + F.lane] = (F.lane == 0) ? s : 0.f;
        } else {
#pragma unroll
            for (int j = 0; j < 8; ++j) { xf[64 * j] = (f32x4){0.f, 0.f, 0.f, 0.f}; xb[64 * j] = (u32x2){0u, 0u}; }
            if (F.lane < 32) F.SS[(size_t)m * 32 + F.lane] = 0.f;
        }
    }
    const int gt = F.bid * NTHR + F.tid, NGT = F.G * NTHR;
    for (int i = gt; i < DEPTH * NG * SP; i += NGT) {
        const int l = i / (NG * SP), gp = i % (NG * SP), g = gp / SP;
        const double dt = exp((double)F.in[I_LDT][l * NG + g]), lr = F.in[I_ARE][i], li = F.in[I_AIM][i];
        const double mag = exp(lr * dt), ang = li * dt, abr = mag * cos(ang), abi = mag * sin(ang), nr = abr - 1.0, den = lr * lr + li * li;
        const double cr = (nr * lr + abi * li) / den, ci = (abi * lr - nr * li) / den;
        float* sp = F.SPp + (size_t)l * SPL;
        sp[gp] = (float)abr; sp[NG * SP + gp] = (float)abi;
#ifdef SCAN_OLD
        { float* so = F.SPo + (size_t)l * SPLO; so[gp] = (float)abr; so[NG * SP + gp] = (float)abi;
          for (int c = 0; c < 16; ++c) { const double br = F.in[I_BRE][(size_t)i * 16 + c], bi = F.in[I_BIM][(size_t)i * 16 + c]; so[2 * NG * SP + gp * 16 + c] = (float)(cr * br - ci * bi); so[2 * NG * SP + NG * SP * 16 + gp * 16 + c] = (float)(cr * bi + ci * br); } }
#endif
        const float* bre = F.in[I_BRE] + (size_t)i * 16; const float* bim = F.in[I_BIM] + (size_t)i * 16;
        const int p = gp % SP;
        bf16_t* bbh = (bf16_t*)(sp + 2 * NG * SP) + (size_t)g * 4 * 512 + (p >> 5) * 512 + (p & 31) * 16;
        unsigned wr_[8], wi_[8];
#pragma unroll
        for (int c = 0; c < 16; c += 2) { const double br0 = bre[c], bi0 = bim[c], br1 = bre[c + 1], bi1 = bim[c + 1];
            wr_[c >> 1] = pk2((float)(cr * br0 - ci * bi0), (float)(cr * br1 - ci * bi1)); wi_[c >> 1] = pk2((float)(cr * bi0 + ci * br0), (float)(cr * bi1 + ci * br1)); }
        *(u32x4*)(bbh) = (u32x4){wr_[0], wr_[1], wr_[2], wr_[3]}; *(u32x4*)(bbh + 8) = (u32x4){wr_[4], wr_[5], wr_[6], wr_[7]};
        *(u32x4*)(bbh + 2 * 512) = (u32x4){wi_[0], wi_[1], wi_[2], wi_[3]}; *(u32x4*)(bbh + 2 * 512 + 8) = (u32x4){wi_[4], wi_[5], wi_[6], wi_[7]};
    }
    for (int i = gt; i < DEPTH * NG * 16 * 64; i += NGT) {
        const int l = i / (NG * 16 * 64), rem = i % (NG * 16 * 64);
        bf16_t* cch = (bf16_t*)(F.SPp + (size_t)l * SPL + 2 * NG * SP + NG * SP * 16);
        ((unsigned*)cch)[rem] = pk2(F.in[I_CRE][i], -F.in[I_CIM][i]);
    }
}

#define MFMA32(a, b, c) __builtin_amdgcn_mfma_f32_32x32x16_bf16((a), (b), (c), 0, 0, 0)
__device__ __forceinline__ int crow(int r, int h) { return (r & 3) + 8 * (r >> 2) + 4 * h; }
__device__ __forceinline__ void attn_wave(const bf16_t* qrow, LAS const unsigned char* ks, LAS const unsigned char* vt, int lo, int hi, float sinkv, bf16_t* orow, float* ssp, int lane) {
    const int n = lane & 31, h = lane >> 5;
    bf16x8 qf[4];
#pragma unroll
    for (int kk = 0; kk < 4; ++kk) qf[kk] = *(const bf16x8*)(qrow + 16 * kk + 8 * h);
    f32x16 st[5];
#pragma unroll
    for (int kt = 0; kt < 5; ++kt) {
#pragma unroll
        for (int i = 0; i < 16; ++i) st[kt][i] = 0.f;
        asm volatile("" : "+v"(st[kt]));
#pragma unroll
        for (int kk = 0; kk < 4; ++kk) { const bf16x8 kf = *(LAS const bf16x8*)(ks + (32 * kt + n) * KS_STRIDE + (16 * kk + 8 * h) * 2); st[kt] = MFMA32(kf, qf[kk], st[kt]); }
        __builtin_amdgcn_sched_barrier(0);
    }
    float mx = -INFINITY;
#pragma unroll
    for (int kt = 0; kt < 5; ++kt)
#pragma unroll
        for (int i = 0; i < 16; ++i) { const int jj = 32 * kt + crow(i, h); const bool ok = (jj >= lo) && (jj <= hi); const float s = ok ? st[kt][i] * 0.125f : -INFINITY; st[kt][i] = s; mx = fmaxf(mx, s); }
    mx = fmaxf(mx, __shfl_xor(mx, 32)); mx = fmaxf(mx, sinkv);
    float sum = 0.f;
#pragma unroll
    for (int kt = 0; kt < 5; ++kt)
#pragma unroll
        for (int i = 0; i < 16; ++i) { const float p = __expf(st[kt][i] - mx); st[kt][i] = p; sum += p; }
    sum += __shfl_xor(sum, 32);
    const float inv = 1.0f / (sum + __expf(sinkv - mx));
    f32x16 o[2];
#pragma unroll
    for (int i = 0; i < 16; ++i) { o[0][i] = 0.f; o[1][i] = 0.f; }
    asm volatile("" : "+v"(o[0]), "+v"(o[1]));
#pragma unroll
    for (int kt = 0; kt < 5; ++kt)
#pragma unroll
        for (int s = 0; s < 2; ++s) {
            u32x4 pw; pw.x = pk2(st[kt][8 * s + 0], st[kt][8 * s + 1]); pw.y = pk2(st[kt][8 * s + 2], st[kt][8 * s + 3]); pw.z = pk2(st[kt][8 * s + 4], st[kt][8 * s + 5]); pw.w = pk2(st[kt][8 * s + 6], st[kt][8 * s + 7]);
            const bf16x8 pb = __builtin_bit_cast(bf16x8, pw);
#pragma unroll
            for (int dt = 0; dt < 2; ++dt) { LAS const unsigned char* vp = vt + (32 * dt + n) * VT_STRIDE + (32 * kt + 16 * s + 4 * h) * 2;
                const u32x2 a0 = *(LAS const u32x2*)vp, a1 = *(LAS const u32x2*)(vp + 16); u32x4 aw; aw.x = a0.x; aw.y = a0.y; aw.z = a1.x; aw.w = a1.y;
                o[dt] = MFMA32(__builtin_bit_cast(bf16x8, aw), pb, o[dt]); }
            __builtin_amdgcn_sched_barrier(0);
        }
    float sq = 0.f;
#pragma unroll
    for (int dt = 0; dt < 2; ++dt)
#pragma unroll
        for (int ig = 0; ig < 4; ++ig) { const float v0 = o[dt][4 * ig] * inv, v1 = o[dt][4 * ig + 1] * inv, v2 = o[dt][4 * ig + 2] * inv, v3 = o[dt][4 * ig + 3] * inv;
            sq += (v0 * v0 + v1 * v1) + (v2 * v2 + v3 * v3); u32x2 w; w.x = pk2(v0, v1); w.y = pk2(v2, v3); *(u32x2*)(orow + 32 * dt + 8 * ig + 4 * h) = w; }
    sq += __shfl_xor(sq, 32);
    if (h == 0) *ssp = sq;
}
__device__ __forceinline__ void vt_scatter(LAS unsigned char* lds, int row, int c8, u32x4 vv) {
    LAS bf16_t* vb = (LAS bf16_t*)(lds + ATT_V_OFF + (8 * c8) * VT_STRIDE + row * 2);
    vb[0 * (VT_STRIDE / 2)] = (bf16_t)(vv.x & 0xffffu); vb[1 * (VT_STRIDE / 2)] = (bf16_t)(vv.x >> 16); vb[2 * (VT_STRIDE / 2)] = (bf16_t)(vv.y & 0xffffu); vb[3 * (VT_STRIDE / 2)] = (bf16_t)(vv.y >> 16);
    vb[4 * (VT_STRIDE / 2)] = (bf16_t)(vv.z & 0xffffu); vb[5 * (VT_STRIDE / 2)] = (bf16_t)(vv.z >> 16); vb[6 * (VT_STRIDE / 2)] = (bf16_t)(vv.w & 0xffffu); vb[7 * (VT_STRIDE / 2)] = (bf16_t)(vv.w >> 16);
}
__device__ __forceinline__ void phase_attention(Frame& F, int l) {
    const bf16_t* Z = F.Z; float* ss_attn = F.SS + (size_t)(4 * l + 1) * MP * 32;
    const float* sink = F.in[I_SINK] + l * 16;
    for (int unit = F.bid; unit < 256 + 2 * DECB; unit += F.G) {
        __syncthreads();
        if (unit < 256) {
            const int b = unit >> 7, nb = (unit >> 2) & 31, kvh = (unit >> 1) & 1, qh = unit & 1;
            const int t0 = 128 * (nb - 1) + 64 * qh;
            for (int ch = F.tid; ch < 192 * 8; ch += NTHR) { const int row = ch >> 3, c8 = ch & 7, pos = t0 + row;
                u32x4 kv = (u32x4){0u, 0u, 0u, 0u}, vv = kv;
                if (pos >= 0) { const bf16_t* zr = Z + (size_t)(b * SEQ + pos) * DIN + kvh * 64 + 8 * c8; kv = *(const u32x4*)(zr + ZK); vv = *(const u32x4*)(zr + ZV); }
                *(LAS u32x4*)(F.lds + row * KS_STRIDE + c8 * 16) = kv; vt_scatter(F.lds, row, c8, vv); }
            if (nb == 31 && qh == 1) {
                for (int idx = F.tid; idx < 128 * 16; idx += NTHR) { const int w = idx >> 4, c = idx & 15; const bf16_t* zr = Z + (size_t)(b * SEQ + SEQ - WIN + w) * DIN + kvh * 64 + 4 * c;
                    const u32x2 kk = *(const u32x2*)(zr + ZK), vv = *(const u32x2*)(zr + ZV); const size_t oo = ((((size_t)l * NBATCH + b) * WIN + w) * NKV + kvh) * HD + 4 * c;
                    *(f32x4*)(F.out + O_KP + oo) = (f32x4){bflo(kk.x), bfhi(kk.x), bflo(kk.y), bfhi(kk.y)}; *(f32x4*)(F.out + O_VP + oo) = (f32x4){bflo(vv.x), bfhi(vv.x), bflo(vv.y), bfhi(vv.y)}; }
            }
            __syncthreads();
            const int n = F.lane & 31, head = kvh * 8 + F.wave;
#pragma unroll 1
            for (int sb = 0; sb < 2; ++sb) { const int s = 2 * qh + sb; const int row = b * SEQ + nb * 128 + 32 * s + n;
                int lo = n + 1; if (nb == 0) lo = max(lo, 128 - 32 * s);
                attn_wave(Z + (size_t)row * DIN + ZQ + head * 64, F.lds + 32 * sb * KS_STRIDE, F.lds + ATT_V_OFF + 32 * sb * 2, lo, n + 128, sink[head], F.CAT + (size_t)row * DM + head * 64, ss_attn + (size_t)row * 32 + head, F.lane); }
        } else {
            const int u2 = unit - 256, b = u2 >> 1, kvh = u2 & 1;
            for (int ch = F.tid; ch < 160 * 8; ch += NTHR) { const int row = ch >> 3, c8 = ch & 7;
                u32x4 kv = (u32x4){0u, 0u, 0u, 0u}, vv = kv;
                if (row < 128) { const size_t ci = ((((size_t)l * DECB + b) * WIN + row) * NKV + kvh) * HD + 8 * c8;
                    const f32x4 k0 = *(const f32x4*)(F.in[I_CK] + ci), k1 = *(const f32x4*)(F.in[I_CK] + ci + 4), v0 = *(const f32x4*)(F.in[I_CV] + ci), v1 = *(const f32x4*)(F.in[I_CV] + ci + 4);
                    kv.x = pk2(k0[0], k0[1]); kv.y = pk2(k0[2], k0[3]); kv.z = pk2(k1[0], k1[1]); kv.w = pk2(k1[2], k1[3]);
                    vv.x = pk2(v0[0], v0[1]); vv.y = pk2(v0[2], v0[3]); vv.z = pk2(v1[0], v1[1]); vv.w = pk2(v1[2], v1[3]);
                    if (row >= DECS) { const size_t oo = ((((size_t)l * DECB + b) * WIN + (row - DECS)) * NKV + kvh) * HD + 8 * c8;
                        *(f32x4*)(F.out + O_KS + oo) = k0; *(f32x4*)(F.out + O_KS + oo + 4) = k1; *(f32x4*)(F.out + O_VS + oo) = v0; *(f32x4*)(F.out + O_VS + oo + 4) = v1; }
                } else if (row < 128 + DECS) { const bf16_t* zr = Z + (size_t)(MPR + DECS * b + (row - 128)) * DIN + kvh * 64 + 8 * c8; kv = *(const u32x4*)(zr + ZK); vv = *(const u32x4*)(zr + ZV);
                    const size_t oo = ((((size_t)l * DECB + b) * WIN + (row - DECS)) * NKV + kvh) * HD + 8 * c8;
                    *(f32x4*)(F.out + O_KS + oo) = (f32x4){bflo(kv.x), bfhi(kv.x), bflo(kv.y), bfhi(kv.y)}; *(f32x4*)(F.out + O_KS + oo + 4) = (f32x4){bflo(kv.z), bfhi(kv.z), bflo(kv.w), bfhi(kv.w)};
                    *(f32x4*)(F.out + O_VS + oo) = (f32x4){bflo(vv.x), bfhi(vv.x), bflo(vv.y), bfhi(vv.y)}; *(f32x4*)(F.out + O_VS + oo + 4) = (f32x4){bflo(vv.z), bfhi(vv.z), bflo(vv.w), bfhi(vv.w)}; }
                *(LAS u32x4*)(F.lds + row * KS_STRIDE + c8 * 16) = kv; vt_scatter(F.lds, row, c8, vv); }
            __syncthreads();
            if (F.wave == 0) { const int n = F.lane & 31, t = n & 3, head = kvh * 8 + (n >> 2), row = MPR + DECS * b + t;
                attn_wave(Z + (size_t)row * DIN + ZQ + head * 64, F.lds, F.lds + ATT_V_OFF, t + 1, t + 128, sink[head], F.CAT + (size_t)row * DM + head * 64, ss_attn + (size_t)row * 32 + head, F.lane); }
        }
    }
}

__device__ __forceinline__ void wave_lds_sync() { asm volatile("s_waitcnt lgkmcnt(0)" ::: "memory"); __builtin_amdgcn_wave_barrier(); asm volatile("" ::: "memory"); }
__device__ __forceinline__ float gelu_as(float v) {
    const float t = __builtin_amdgcn_rcpf(fmaf(fabsf(v), 0.2316418882f, 1.0f));
    float q = fmaf(t, 0.5307027145f, -0.7265760135f); q = fmaf(q, t, 0.7107068705f); q = fmaf(q, t, -0.142248368f); q = fmaf(q, t, 0.127414796f); q = q * t;
    const float e = __builtin_amdgcn_exp2f((v * v) * (-0.72134752044f));
    const float mm = v * (q * e);
    return v < 0.f ? mm : v - mm;
}
#define SCAN_BU(rowbase) do { \
        const bf16x8 uf_ = *(const bf16x8*)(F.Z + (size_t)((rowbase) + n32) * DIN + ZU + 16 * g + 8 * h2); \
        _Pragma("unroll") for (int nt_ = 0; nt_ < 4; ++nt_) { f32x16 d_; _Pragma("unroll") for (int r = 0; r < 16; ++r) d_[r] = 0.f; asm volatile("" : "+v"(d_)); d_ = MFMA32(uf_, bbf[nt_], d_); asm volatile("s_nop 15\n\ts_nop 15\n\ts_nop 15\n\ts_nop 15" : "+v"(d_)); \
            _Pragma("unroll") for (int r = 0; r < 16; ++r) BU[crow(r, h2) * HB_STRIDE + 32 * nt_ + n32] = d_[r]; } } while (0)
#ifdef PARAM_SC1
#define SCAN_LOAD_PARAMS() \
        bf16x8 bbf[4]; { const unsigned* bbh = (const unsigned*)((const bf16_t*)(sp + 2 * NG * SP) + (size_t)g * 4 * 512 + n32 * 16 + 8 * h2); \
            _Pragma("unroll") for (int nt_ = 0; nt_ < 4; ++nt_) { u32x4 w_; w_.x = __hip_atomic_load(bbh + nt_ * 256 + 0, __ATOMIC_RELAXED, __HIP_MEMORY_SCOPE_AGENT); w_.y = __hip_atomic_load(bbh + nt_ * 256 + 1, __ATOMIC_RELAXED, __HIP_MEMORY_SCOPE_AGENT); \
                w_.z = __hip_atomic_load(bbh + nt_ * 256 + 2, __ATOMIC_RELAXED, __HIP_MEMORY_SCOPE_AGENT); w_.w = __hip_atomic_load(bbh + nt_ * 256 + 3, __ATOMIC_RELAXED, __HIP_MEMORY_SCOPE_AGENT); bbf[nt_] = __builtin_bit_cast(bf16x8, w_); } } \
        const float ar = __hip_atomic_load(sp + g * SP + p, __ATOMIC_RELAXED, __HIP_MEMORY_SCOPE_AGENT), ai = __hip_atomic_load(sp + NG * SP + g * SP + p, __ATOMIC_RELAXED, __HIP_MEMORY_SCOPE_AGENT);
#else
#define SCAN_LOAD_PARAMS() \
        bf16x8 bbf[4]; { const bf16_t* bbh = (const bf16_t*)(sp + 2 * NG * SP) + (size_t)g * 4 * 512 + n32 * 16 + 8 * h2; \
            _Pragma("unroll") for (int nt_ = 0; nt_ < 4; ++nt_) bbf[nt_] = *(const bf16x8*)(bbh + nt_ * 512); } \
        const float ar = sp[g * SP + p], ai = sp[NG * SP + g * SP + p];
#endif

__device__ __forceinline__ void phase_scan_a(Frame& F, int l) {
    LAS float* BU = (LAS float*)(F.lds + F.wave * SCAN_WAVE_BYTES);
    const float* sp = F.SPp + (size_t)l * SPL; const int p = F.lane, n32 = F.lane & 31, h2 = F.lane >> 5;
    const int gw = F.bid * NWAVES + F.wave, NGW = F.G * NWAVES;
    for (int task = gw; task < NBATCH * NG * 31; task += NGW) {
        const int c = task % 31, bg = task / 31, g = bg % NG, b = bg / NG, row0 = b * SEQ + c * 128;
        SCAN_LOAD_PARAMS();
        float hr = 0.f, hi = 0.f;
#pragma unroll 1
        for (int t0 = 0; t0 < 128; t0 += 32) {
            wave_lds_sync();
            SCAN_BU(row0 + t0);
            wave_lds_sync();
#pragma unroll 8
            for (int tt = 0; tt < 32; ++tt) { const float br = BU[tt * HB_STRIDE + p], bi = BU[tt * HB_STRIDE + 64 + p];
                const float nr_ = fmaf(ar, hr, fmaf(-ai, hi, br)), ni_ = fmaf(ar, hi, fmaf(ai, hr, bi)); hr = nr_; hi = ni_; }
        }
        *(float2*)(F.SC + ((size_t)(bg * 32 + c) * SP + p) * 2) = make_float2(hr, hi);
    }
}
__device__ __forceinline__ void phase_scan_c(Frame& F, int l) {
    LAS float* BU = (LAS float*)(F.lds + F.wave * SCAN_WAVE_BYTES);
    const float* sp = F.SPp + (size_t)l * SPL; const int p = F.lane, n32 = F.lane & 31, h2 = F.lane >> 5;
    const int gw = F.bid * NWAVES + F.wave, NGW = F.G * NWAVES;
    constexpr int NPT = NBATCH * NG * 32, NST = DECB * NG;
    for (int task = gw; task < NPT + NST; task += NGW) {
        int c, g, b, row0, T; const bool prompt = task < NPT;
        if (prompt) { c = task % 32; const int bg = task / 32; g = bg % NG; b = bg / NG; row0 = b * SEQ + c * 128; T = 128; }
        else { const int t2 = task - NPT; c = 0; g = t2 % NG; b = t2 / NG; row0 = MPR + DECS * b; T = DECS; }
        SCAN_LOAD_PARAMS();
        unsigned chk0 = 0u, chs0 = 0u;
#ifdef SELFCHECK_C
        int nrep2 = 2; asm volatile("" : "+s"(nrep2));
#pragma unroll 1
        for (int rep2 = 0; rep2 < nrep2; ++rep2) {
#else
        { const int rep2 = 0;
#endif
        unsigned chk = 0u, chs = 0u;
        float hr = 0.f, hi = 0.f;
        if (prompt) {
            float tr = ar, ti = ai;
#pragma unroll
            for (int q = 0; q < 7; ++q) { const float xr = fmaf(tr, tr, -(ti * ti)), xi = (2.f * tr) * ti; tr = xr; ti = xi; }
            const float2* scp = (const float2*)F.SC + (size_t)((b * NG + g) * 32) * SP + p;
            VMW0();
#pragma unroll 1
            for (int j = 0; j < c; ++j) { float2 s = scp[(size_t)j * SP]; VMW0V(s.x, s.y); const float xr = fmaf(tr, hr, fmaf(-ti, hi, s.x)), xi = fmaf(tr, hi, fmaf(ti, hr, s.y)); hr = xr; hi = xi;
#if defined(CHK_SC_ONLY) || defined(CHK_INPUTS)
                chk = chk * 31u + __builtin_bit_cast(unsigned, s.x); chk = chk * 31u + __builtin_bit_cast(unsigned, s.y);
#endif
                chs = chs * 31u + __builtin_bit_cast(unsigned, s.x); chs = chs * 31u + __builtin_bit_cast(unsigned, s.y); chs = chs * 31u + __builtin_bit_cast(unsigned, tr); chs = chs * 31u + __builtin_bit_cast(unsigned, ti);
            }
        } else { const size_t si = (((size_t)l * DECB + b) * NG + g) * SP + p; hr = F.in[I_SRE][si]; hi = F.in[I_SIM][si]; }
#ifdef CHK_INPUTS
        chk = chk * 31u + __builtin_bit_cast(unsigned, ar); chk = chk * 31u + __builtin_bit_cast(unsigned, ai); chk = chk * 31u + __builtin_bit_cast(unsigned, hr); chk = chk * 31u + __builtin_bit_cast(unsigned, hi);
#endif
#ifdef CHK_AR_ONLY
        chk = chk * 31u + __builtin_bit_cast(unsigned, ar); chk = chk * 31u + __builtin_bit_cast(unsigned, ai);
#endif
#ifdef CHK_INIT_ONLY
        chk = chk * 31u + __builtin_bit_cast(unsigned, hr); chk = chk * 31u + __builtin_bit_cast(unsigned, hi);
#endif
        bf16x8 ccf[8];
        { const bf16_t* cch = (const bf16_t*)(sp + 2 * NG * SP + NG * SP * 16) + ((size_t)g * 16 + (n32 & 15)) * 128 + 8 * h2;
#pragma unroll
          for (int s = 0; s < 8; ++s) { bf16x8 v = *(const bf16x8*)(cch + 16 * s); if (n32 >= 16) v = (bf16x8){0, 0, 0, 0, 0, 0, 0, 0}; ccf[s] = v; } }
        f32x4 dv[2];
#pragma unroll
        for (int q = 0; q < 2; ++q) dv[q] = *(const f32x4*)(F.in[I_D] + l * SW + g * 16 + 8 * q + 4 * h2);
#pragma unroll 1
        for (int t0 = 0; t0 < T; t0 += 32) {
            const int nt = min(32, T - t0);
            wave_lds_sync();
            SCAN_BU(row0 + t0);
            wave_lds_sync();
#ifdef BU_VALU
            for (int tt = 0; tt < nt; ++tt) { float br = 0.f, bi = 0.f;
                const u32x4* up = (const u32x4*)(F.Z + (size_t)(row0 + t0 + tt) * DIN + ZU + 16 * g); const u32x4 ua = up[0], ub = up[1];
                {
                  const float uu_[16] = {bflo(ua.x), bfhi(ua.x), bflo(ua.y), bfhi(ua.y), bflo(ua.z), bfhi(ua.z), bflo(ua.w), bfhi(ua.w), bflo(ub.x), bfhi(ub.x), bflo(ub.y), bfhi(ub.y), bflo(ub.z), bfhi(ub.z), bflo(ub.w), bfhi(ub.w)};
                  const bf16_t* bre_ = (const bf16_t*)(sp + 2 * NG * SP) + (size_t)g * 4 * 512 + (p >> 5) * 512 + (p & 31) * 16;
#pragma unroll
                  for (int c_ = 0; c_ < 16; ++c_) { br += bf2f(bre_[c_]) * uu_[c_]; bi += bf2f(bre_[2 * 512 + c_]) * uu_[c_]; } }
#if defined(CHK_U_ONLY) || defined(CHK_INPUTS)
                chk = chk * 31u + ua.x + ua.y * 3u + ua.z * 5u + ua.w * 7u + ub.x * 11u + ub.y * 13u + ub.z * 17u + ub.w * 19u;
#endif
#if defined(CHK_BR_ONLY) || defined(CHK_INPUTS)
                chk = chk * 31u + __builtin_bit_cast(unsigned, br); chk = chk * 31u + __builtin_bit_cast(unsigned, bi);
#endif
#else
            for (int tt = 0; tt < nt; ++tt) { const float br = BU[tt * HB_STRIDE + p], bi = BU[tt * HB_STRIDE + 64 + p];
#endif
#ifdef NO_PK
                float t1_ = fmaf(-ai, hi, br); asm volatile("" : "+v"(t1_)); float t2_ = fmaf(ai, hr, bi); asm volatile("" : "+v"(t2_));
                float nr_ = fmaf(ar, hr, t1_); asm volatile("" : "+v"(nr_)); float ni_ = fmaf(ar, hi, t2_); asm volatile("" : "+v"(ni_)); hr = nr_; hi = ni_;
#else
                const float nr_ = fmaf(ar, hr, fmaf(-ai, hi, br)), ni_ = fmaf(ar, hi, fmaf(ai, hr, bi)); hr = nr_; hi = ni_;
#endif
                BU[tt * HB_STRIDE + p] = __builtin_bit_cast(float, CVT_HH(hr, hi)); }
            wave_lds_sync();
            f32x16 y;
#pragma unroll
            for (int r = 0; r < 16; ++r) y[r] = 0.f;
            asm volatile("" : "+v"(y));
#pragma unroll
            for (int s = 0; s < 8; ++s) { const bf16x8 hf = *(const LAS bf16x8*)((const LAS unsigned char*)BU + n32 * (HB_STRIDE * 4) + 32 * s + 16 * h2); y = MFMA32(ccf[s], hf, y); }
            asm volatile("s_nop 15\n\ts_nop 15\n\ts_nop 15\n\ts_nop 15" : "+v"(y));
            if (n32 < nt) { const size_t row = (size_t)(row0 + t0 + n32);
#pragma unroll
                for (int q = 0; q < 2; ++q) { const int ch0 = 16 * g + 8 * q + 4 * h2; const u32x2 uu = *(const u32x2*)(F.Z + row * DIN + ZU + ch0);
                    const float u4[4] = {bflo(uu.x), bfhi(uu.x), bflo(uu.y), bfhi(uu.y)}; float z4[4];
#pragma unroll
                    for (int e2 = 0; e2 < 4; ++e2) { const float yy = fmaf(dv[q][e2], u4[e2], y[4 * q + e2]); z4[e2] = gelu_as(yy); }
                    u32x2 w; w.x = pg8::cvt_pk_bf16(z4[0], z4[1]); w.y = pg8::cvt_pk_bf16(z4[2], z4[3]);
#ifndef CHK_STATE_ONLY
                    chk = chk * 31u + w.x; chk = chk * 31u + w.y;
#endif
                    if (rep2 == 0) *(u32x2*)(F.ZS + row * SW + ch0) = w; } }
        }
        if (prompt) { if (c == 31) { const size_t oi = (((size_t)l * NBATCH + b) * NG + g) * SP + p; F.out[O_HRP + oi] = hr; F.out[O_HIP + oi] = hi; } }
        else { const size_t oi = (((size_t)l * DECB + b) * NG + g) * SP + p; F.out[O_HRS + oi] = hr; F.out[O_HIS + oi] = hi; }
#if !defined(CHK_SC_ONLY) && !defined(CHK_U_ONLY) && !defined(CHK_BR_ONLY) && !defined(CHK_INPUTS) && !defined(CHK_AR_ONLY) && !defined(CHK_INIT_ONLY)
        chk = chk * 31u + __builtin_bit_cast(unsigned, hr); chk = chk * 31u + __builtin_bit_cast(unsigned, hi);
#endif
        if (rep2 == 0) { chk0 = chk; chs0 = chs; } else if (chk != chk0 && (!CHK_SAME_IN || chs == chs0) && (CHK_WHICH == 2 || (CHK_WHICH == 1) == prompt)) F.ZS[(size_t)row0 * SW + 16 * g + (F.lane & 15)] = (bf16_t)0xffffu;
        }
    }
}
#ifdef SCAN_OLD
__device__ __forceinline__ void scan_load_u(const bf16_t* Z, int row0, int T, int g, LAS float* UB, int lane) {
    for (int ch = lane; ch < 2 * T; ch += 64) { const int tok = ch >> 1, hf = ch & 1; const u32x4 v = *(const u32x4*)(Z + (size_t)(row0 + tok) * DIN + ZU + 16 * g + 8 * hf);
        *(LAS f32x4*)(UB + tok * 16 + 8 * hf) = (f32x4){bflo(v.x), bfhi(v.x), bflo(v.y), bfhi(v.y)}; *(LAS f32x4*)(UB + tok * 16 + 8 * hf + 4) = (f32x4){bflo(v.z), bfhi(v.z), bflo(v.w), bfhi(v.w)}; }
}
#define SCAN_STEP(t) do { const LAS f32x4* up = (const LAS f32x4*)(UB + (t) * 16); const f32x4 u0 = up[0], u1 = up[1], u2 = up[2], u3 = up[3]; \
        float br = 0.f, bi = 0.f; \
        _Pragma("unroll") for (int c = 0; c < 4; ++c) { br += bbr[c] * u0[c]; bi += bbi[c] * u0[c]; } \
        _Pragma("unroll") for (int c = 0; c < 4; ++c) { br += bbr[4 + c] * u1[c]; bi += bbi[4 + c] * u1[c]; } \
        _Pragma("unroll") for (int c = 0; c < 4; ++c) { br += bbr[8 + c] * u2[c]; bi += bbi[8 + c] * u2[c]; } \
        _Pragma("unroll") for (int c = 0; c < 4; ++c) { br += bbr[12 + c] * u3[c]; bi += bbi[12 + c] * u3[c]; } \
        const float nr_ = ar * hr - ai * hi + br, ni_ = ar * hi + ai * hr + bi; hr = nr_; hi = ni_; } while (0)

__device__ __forceinline__ void phase_scan_a_old(Frame& F, int l) {
    LAS float* UB = (LAS float*)(F.lds + F.wave * SCAN_WAVE_BYTES);
    const float* sp = F.SPo + (size_t)l * SPLO; const int p = F.lane;
    const int gw = F.bid * NWAVES + F.wave, NGW = F.G * NWAVES;
    for (int task = gw; task < NBATCH * NG * 31; task += NGW) {
        const int c = task % 31, bg = task / 31, g = bg % NG, b = bg / NG;
        wave_lds_sync();
        scan_load_u(F.Z, b * SEQ + c * 128, 128, g, UB, F.lane);
        float bbr[16], bbi[16];
#pragma unroll
        for (int q = 0; q < 4; ++q) { const f32x4 x = *(const f32x4*)(sp + 2 * NG * SP + (g * SP + p) * 16 + 4 * q), y = *(const f32x4*)(sp + 2 * NG * SP + NG * SP * 16 + (g * SP + p) * 16 + 4 * q);
            bbr[4 * q] = x[0]; bbr[4 * q + 1] = x[1]; bbr[4 * q + 2] = x[2]; bbr[4 * q + 3] = x[3]; bbi[4 * q] = y[0]; bbi[4 * q + 1] = y[1]; bbi[4 * q + 2] = y[2]; bbi[4 * q + 3] = y[3]; }
        const float ar = sp[g * SP + p], ai = sp[NG * SP + g * SP + p];
        float hr = 0.f, hi = 0.f;
        wave_lds_sync();
#pragma unroll 4
        for (int t = 0; t < 128; ++t) SCAN_STEP(t);
        *(float2*)(F.SC + ((size_t)(bg * 32 + c) * SP + p) * 2) = make_float2(hr, hi);
    }
}
__device__ __forceinline__ void phase_scan_c_old(Frame& F, int l) {
    LAS float* UB = (LAS float*)(F.lds + F.wave * SCAN_WAVE_BYTES); LAS float* HB = UB + 2048;
    const float* sp = F.SPo + (size_t)l * SPLO; const int p = F.lane, ch = F.lane & 15, tq = F.lane >> 4;
    const int gw = F.bid * NWAVES + F.wave, NGW = F.G * NWAVES;
    constexpr int NPT = NBATCH * NG * 32, NST = DECB * NG;
    for (int task = gw; task < NPT + NST; task += NGW) {
        int c, g, b, row0, T; const bool prompt = task < NPT;
        if (prompt) { c = task % 32; const int bg = task / 32; g = bg % NG; b = bg / NG; row0 = b * SEQ + c * 128; T = 128; }
        else { const int t2 = task - NPT; c = 0; g = t2 % NG; b = t2 / NG; row0 = MPR + DECS * b; T = DECS; }
        wave_lds_sync();
        scan_load_u(F.Z, row0, T, g, UB, F.lane);
        float bbr[16], bbi[16];
#pragma unroll
        for (int q = 0; q < 4; ++q) { const f32x4 x = *(const f32x4*)(sp + 2 * NG * SP + (g * SP + p) * 16 + 4 * q), y = *(const f32x4*)(sp + 2 * NG * SP + NG * SP * 16 + (g * SP + p) * 16 + 4 * q);
            bbr[4 * q] = x[0]; bbr[4 * q + 1] = x[1]; bbr[4 * q + 2] = x[2]; bbr[4 * q + 3] = x[3]; bbi[4 * q] = y[0]; bbi[4 * q + 1] = y[1]; bbi[4 * q + 2] = y[2]; bbi[4 * q + 3] = y[3]; }
        const float ar = sp[g * SP + p], ai = sp[NG * SP + g * SP + p];
        float hr = 0.f, hi = 0.f;
        if (prompt) {
            float tr = ar, ti = ai;
#pragma unroll
            for (int q = 0; q < 7; ++q) { const float xr = fmaf(tr, tr, -(ti * ti)), xi = (2.f * tr) * ti; tr = xr; ti = xi; }
            const float2* scp = (const float2*)F.SC + (size_t)((b * NG + g) * 32) * SP + p;
            for (int j = 0; j < c; ++j) { const float2 s = scp[(size_t)j * SP]; const float xr = fmaf(tr, hr, fmaf(-ti, hi, s.x)), xi = fmaf(tr, hi, fmaf(ti, hr, s.y)); hr = xr; hi = xi; }
        } else { const size_t si = (((size_t)l * DECB + b) * NG + g) * SP + p; hr = F.in[I_SRE][si]; hi = F.in[I_SIM][si]; }
        float cre[16], cim[16];
        { const float* cr = F.in[I_CRE] + (((size_t)l * NG + g) * 16 + ch) * SP + 16 * tq; const float* ci = F.in[I_CIM] + (((size_t)l * NG + g) * 16 + ch) * SP + 16 * tq;
#pragma unroll
          for (int q = 0; q < 4; ++q) { const f32x4 x = *(const f32x4*)(cr + 4 * q), y = *(const f32x4*)(ci + 4 * q);
              cre[4 * q] = x[0]; cre[4 * q + 1] = x[1]; cre[4 * q + 2] = x[2]; cre[4 * q + 3] = x[3]; cim[4 * q] = y[0]; cim[4 * q + 1] = y[1]; cim[4 * q + 2] = y[2]; cim[4 * q + 3] = y[3]; } }
        const float dch = F.in[I_D][l * SW + g * 16 + ch];
        wave_lds_sync();
        for (int t0 = 0; t0 < T; t0 += 16) {
            const int nt = min(16, T - t0);
            for (int tt = 0; tt < nt; ++tt) { SCAN_STEP(t0 + tt); HB[tt * HB_STRIDE + p] = hr; HB[tt * HB_STRIDE + 64 + p] = hi; }
            wave_lds_sync();
            float ysel[4] = {0.f, 0.f, 0.f, 0.f};
#pragma unroll
            for (int tt = 0; tt < 16; ++tt) {
                if (tt < nt) { const LAS f32x4* hp = (const LAS f32x4*)(HB + tt * HB_STRIDE + 16 * tq); float y0 = 0.f, y1 = 0.f;
#pragma unroll
                    for (int q = 0; q < 4; ++q) { const f32x4 a = hp[q], bq = hp[16 + q];
                        y0 += a[0] * cre[4 * q] + a[1] * cre[4 * q + 1] + a[2] * cre[4 * q + 2] + a[3] * cre[4 * q + 3];
                        y1 += bq[0] * cim[4 * q] + bq[1] * cim[4 * q + 1] + bq[2] * cim[4 * q + 2] + bq[3] * cim[4 * q + 3]; }
                    float y = y0 - y1; y += __shfl_xor(y, 16); y += __shfl_xor(y, 32);
                    if ((tt & 3) == tq) ysel[tt >> 2] = y; } }
#pragma unroll
            for (int i = 0; i < 4; ++i) { const int tt = 4 * i + tq;
                if (tt < nt) { const float y = ysel[i] + dch * UB[(t0 + tt) * 16 + ch];
                    const float z = 0.5f * y * (1.0f + erff(y * 0.70710678118654752f));
                    F.ZS[(size_t)(row0 + t0 + tt) * SW + g * 16 + ch] = (bf16_t)f2bf(z); } }
            wave_lds_sync();
        }
        if (prompt) { if (c == 31) { const size_t oi = (((size_t)l * NBATCH + b) * NG + g) * SP + p; F.out[O_HRP + oi] = hr; F.out[O_HIP + oi] = hi; } }
        else { const size_t oi = (((size_t)l * DECB + b) * NG + g) * SP + p; F.out[O_HRS + oi] = hr; F.out[O_HIS + oi] = hi; }
    }
}
#endif
__device__ __forceinline__ void phase_final(Frame& F) {
    const int gw = F.bid * NWAVES + F.wave, NGW = F.G * NWAVES; const float* ssf = F.SS + (size_t)16 * MP * 32; const f32x4* gf = (const f32x4*)F.in[I_NFIN] + F.lane;
    for (int m = gw; m < MT; m += NGW) { float sp_ = ssf[(size_t)m * 32 + (F.lane & 31)];
#pragma unroll
        for (int o_ = 1; o_ < 32; o_ <<= 1) sp_ += __shfl_xor(sp_, o_);
        const float rs = rsqrtf(sp_ * (1.0f / DM) + EPS); const f32x4* xf = (const f32x4*)(F.XF + (size_t)m * DM) + F.lane; f32x4* o = (f32x4*)(F.out + O_YP + (size_t)m * DM) + F.lane;
#pragma unroll
        for (int j = 0; j < 8; ++j) o[64 * j] = xf[64 * j] * rs * gf[64 * j]; }
}

__device__ __forceinline__ void skinny_res(Frame& F, const bf16_t* A, int K, const bf16_t* Bt, float* ssq, const float* ssp_a, const float* ssp_s, bool mid) {
    LAS float* red = (LAS float*)F.lds;
    const int i = F.lane & 15, kq = F.lane >> 4, kw = K >> 3;
    for (int item = F.bid; item < 256; item += F.G) {
        const int rb = (item >> 3) & 7, cs = (item & 7) + 8 * (item >> 6), row0 = MPR + 16 * rb, col0 = 64 * cs;
        __syncthreads();
        const bf16_t* ap = A + (size_t)(row0 + i) * K + F.wave * kw + 8 * kq;
        const bf16_t* bp = Bt + (size_t)(col0 + i) * K + F.wave * kw + 8 * kq;
        f32x4 acc[4];
#pragma unroll
        for (int cb = 0; cb < 4; ++cb) acc[cb] = (f32x4){0.f, 0.f, 0.f, 0.f};
#pragma unroll 2
        for (int ks = 0; ks < kw; ks += 32) { const bf16x8 a = *(const bf16x8*)(ap + ks);
#pragma unroll
            for (int cb = 0; cb < 4; ++cb) { const bf16x8 b = *(const bf16x8*)(bp + (size_t)cb * 16 * K + ks); acc[cb] = __builtin_amdgcn_mfma_f32_16x16x32_bf16(b, a, acc[cb], 0, 0, 0); } }
#pragma unroll
        for (int cb = 0; cb < 4; ++cb) *(LAS f32x4*)(red + (F.wave * 16 + i) * 64 + 16 * cb + 4 * kq) = acc[cb];
        __syncthreads();
        if (F.tid < 256) { const int r = F.tid >> 4, c4 = (F.tid & 15) * 4, row = row0 + r;
            f32x4 sa = (f32x4){0.f, 0.f, 0.f, 0.f}, sb = sa;
#pragma unroll
            for (int w = 0; w < 4; ++w) { sa += *(const LAS f32x4*)(red + (w * 16 + r) * 64 + c4); sb += *(const LAS f32x4*)(red + ((w + 4) * 16 + r) * 64 + c4); }
            f32x4 val = sa + sb;
            if (mid) { float pa = 0.f, ps = 0.f; const f32x4* qa = (const f32x4*)(ssp_a + (size_t)row * 32); const f32x4* qs = (const f32x4*)(ssp_s + (size_t)row * 32);
#pragma unroll
                for (int q = 0; q < 4; ++q) { const f32x4 x = qa[q], y = qs[q]; pa += (x[0] + x[1]) + (x[2] + x[3]); ps += (y[0] + y[1]) + (y[2] + y[3]); }
                val = sa * rsqrtf(pa * (1.0f / 1024.0f) + EPS) + sb * rsqrtf(ps * (1.0f / 1024.0f) + EPS); }
            const size_t o = (size_t)row * DM + col0 + c4; const f32x4 x = *(const f32x4*)(F.XF + o) + val;
            *(f32x4*)(F.XF + o) = x; u32x2 wv; wv.x = pk2(x[0], x[1]); wv.y = pk2(x[2], x[3]); *(u32x2*)(F.XB + o) = wv;
            float sq = (x[0] * x[0] + x[1] * x[1]) + (x[2] * x[2] + x[3] * x[3]);
            sq += __shfl_xor(sq, 1); sq += __shfl_xor(sq, 2); sq += __shfl_xor(sq, 4); sq += __shfl_xor(sq, 8);
            if ((F.tid & 15) == 0) ssq[(size_t)row * 32 + cs] = sq; }
    }
    __syncthreads();
}
#define XB_TMO      128
#define XB_XCNT(j)  (256  + 64 * (j))
#define XB_XSUB(j)  (1280 + 64 * (j))
#define XB_XGEN(j)  (2304 + 64 * (j))
#define XB_TOP      3328
#define XB_TOPGEN   3392
#define XCD_BAR_WORDS 3456
#define XB_SPIN_CAP (1u << 18)

__device__ __forceinline__ unsigned xb_ld(unsigned* p)              { return __hip_atomic_load(p, __ATOMIC_RELAXED, __HIP_MEMORY_SCOPE_AGENT); }
__device__ __forceinline__ unsigned xb_add(unsigned* p, unsigned v) { return __hip_atomic_fetch_add(p, v, __ATOMIC_RELAXED, __HIP_MEMORY_SCOPE_AGENT); }
__device__ __forceinline__ unsigned xb_xcc_id() { return (unsigned)__builtin_amdgcn_s_getreg((3 << 11) | 20) & 0xFu; }
#define XB_SPIN(cond, bar) do { unsigned _sp = 0; while (cond) { __builtin_amdgcn_s_sleep(1); \
    if ((++_sp & 255u) == 0u) { if (xb_ld(&(bar)[XB_TMO])) break; if (_sp > XB_SPIN_CAP) { atomicAdd(&(bar)[XB_TMO], 1u); break; } } } } while (0)

struct XcdBarrier {
    unsigned* bar; unsigned x;
    volatile LAS unsigned* st;
};

__device__ __forceinline__ XcdBarrier xcd_barrier_post(unsigned* bar, volatile LAS unsigned* st) {
    XcdBarrier b; b.bar = bar; b.x = xb_xcc_id(); b.st = st;
    if (threadIdx.x == 0) (void)xb_add(&bar[XB_XCNT(b.x)], 1u);
    return b;
}
__device__ __forceinline__ void xcd_barrier_complete(unsigned* bar, unsigned x, unsigned& nloc, unsigned& nx) {
    const unsigned G = gridDim.x * gridDim.y * gridDim.z;
    unsigned sum, cnt, mine, sp = 0u;
    for (;;) {
        sum = 0u; cnt = 0u; mine = 0u;
#pragma unroll
        for (unsigned j = 0; j < 16; ++j) { const unsigned c = xb_ld(&bar[XB_XCNT(j)]); sum += c; cnt += (c > 0u) ? 1u : 0u; mine = (j == x) ? c : mine; }
        if (sum == G) break;
        __builtin_amdgcn_s_sleep(1);
        if ((++sp & 255u) == 0u) { if (xb_ld(&bar[XB_TMO])) break; if (sp > XB_SPIN_CAP) { atomicAdd(&bar[XB_TMO], 1u); break; } }
    }
    nloc = mine > 0u ? mine : 1u; nx = cnt > 0u ? cnt : 1u;
}

__device__ __forceinline__ void xcd_barrier(const XcdBarrier& b) {
    asm volatile("s_waitcnt vmcnt(0)" ::: "memory");
    __syncthreads();
    if (threadIdx.x == 0) {
        unsigned* bar = b.bar;
        __builtin_amdgcn_s_waitcnt(0);
        unsigned nloc = b.st[0], nx = b.st[1];
        if (nloc == 0u) { xcd_barrier_complete(bar, b.x, nloc, nx); b.st[0] = nloc; b.st[1] = nx; }
        const unsigned old = xb_add(&bar[XB_XSUB(b.x)], 1u);
        const unsigned gen = old / nloc;
        if (old + 1u == (gen + 1u) * nloc) {
            __builtin_amdgcn_fence(__ATOMIC_RELEASE, "agent");
            asm volatile("s_waitcnt vmcnt(0)" ::: "memory");
            const unsigned og = xb_add(&bar[XB_TOP], 1u);
            const unsigned tg = og / nx;
            if (og + 1u == (tg + 1u) * nx) xb_add(&bar[XB_TOPGEN], 1u);
            else XB_SPIN(xb_ld(&bar[XB_TOPGEN]) == tg, bar);
            __builtin_amdgcn_fence(__ATOMIC_ACQUIRE, "agent");
            xb_add(&bar[XB_XGEN(b.x)], 1u);
            asm volatile("s_waitcnt vmcnt(0)" ::: "memory");
        } else {
            XB_SPIN(xb_ld(&bar[XB_XGEN(b.x)]) == gen, bar);
            __builtin_amdgcn_fence(__ATOMIC_ACQUIRE, "agent");
            asm volatile("s_waitcnt vmcnt(0)" ::: "memory");
        }
    }
    __syncthreads();
}

template <class Sched> __device__ __forceinline__ void prep_rs(const Sched& S, LAS float* tab, const float* ssp, int nq, float invn, int tid) {
    for (int i = tid >> 8; i < 8; i += 2) { pg8::Unit u; if (!S.next(i, u)) break;
        { const int row = tid & 255; const f32x4* pp = (const f32x4*)(ssp + (size_t)(u.pm * 256 + row) * 32); float s = 0.f;
            for (int q = 0; q < nq; ++q) { const f32x4 v = pp[q]; s += (v[0] + v[1]) + (v[2] + v[3]); }
            tab[i * 256 + row] = rsqrtf(s * invn + EPS); } }
    __syncthreads();
}
__global__ void __launch_bounds__(NTHR, 2) mega_fwd(Params P) {
    extern __shared__ __attribute__((aligned(16))) unsigned char lds_raw[];
    cg::grid_group grid = cg::this_grid();
    const int ph_lo = P.ph_lo, ph_hi = P.ph_hi;
    volatile LAS unsigned* misc = (volatile LAS unsigned*)((LAS unsigned char*)lds_raw + MISC_OFF);
#ifdef LDS_POISON
    for (int i_ = threadIdx.x; i_ < MISC_OFF / 4; i_ += NTHR) ((LAS unsigned*)lds_raw)[i_] = LDS_POISON;
#endif
    if (threadIdx.x < 64) misc[threadIdx.x] = 0u;
    __syncthreads();
    XcdBarrier xbar = xcd_barrier_post((unsigned*)(P.ws + WS_CTL), misc);
    if (ph_hi < 0) grid.sync();
    const int wave_s = __builtin_amdgcn_readfirstlane((int)threadIdx.x >> 6);
#define BUILD_FRAME() \
        const CAS Params* pp = (const CAS Params*)__builtin_amdgcn_kernarg_segment_ptr(); asm volatile("" : "+s"(pp)); \
        int tid_ = wave_s * 64 + (int)__builtin_amdgcn_mbcnt_hi(~0u, __builtin_amdgcn_mbcnt_lo(~0u, 0u)); asm volatile("" : "+v"(tid_)); \
        int bid_ = blockIdx.x; asm volatile("" : "+s"(bid_)); \
        int G_ = gridDim.x; asm volatile("" : "+s"(G_)); \
        Frame F; \
        F.lds = (LAS unsigned char*)lds_raw; F.tid = tid_; F.lane = tid_ & 63; F.wave = __builtin_amdgcn_readfirstlane(tid_ >> 6); F.G = G_; F.bid = bid_; \
        F.in = pp->in; F.out = pp->out; F.ws = pp->ws; \
        unsigned char* const ws = F.ws; \
        F.XF = (float*)(ws + WS_XF); F.XB = (bf16_t*)(ws + WS_XB); F.Z = (bf16_t*)(ws + WS_Z); F.CAT = (bf16_t*)(ws + WS_CAT); F.ZS = (bf16_t*)(ws + WS_ZS); F.H = (bf16_t*)(ws + WS_H); \
        F.SS = (float*)(ws + WS_SS); F.SPp = (float*)(ws + WS_SP); F.SC = (float*)(ws + WS_SC); F.SPo = (float*)(ws + WS_SPO);
    int ph = ph_lo;
#ifdef EXTRA_FIRST_BAR
    if (ph == 0) xcd_barrier(xbar);
#endif
#if defined(NAN_POISON) && (NAN_POISON & 64)
    if (ph == 0) { BUILD_FRAME(); const size_t t0_ = (size_t)F.bid * NTHR + F.tid, nt_ = (size_t)F.G * NTHR; const u32x4 nanv = (u32x4){0xffffffffu, 0xffffffffu, 0xffffffffu, 0xffffffffu};
        if (NAN_POISON & 128) for (size_t i = t0_; i < (WS_Z - WS_W) / 16; i += nt_) ((u32x4*)(F.ws + WS_W))[i] = nanv;
        if (NAN_POISON & 256) for (size_t i = t0_; i < ((size_t)MP * 32 * 4) / 16; i += nt_) ((u32x4*)(F.ws + WS_SS))[i] = nanv;
        for (size_t i = t0_; i < (WS_SC - WS_SP) / 16; i += nt_) ((u32x4*)(F.ws + WS_SP))[i] = nanv;
        for (size_t i = t0_; i < (WS_END - WS_SPO) / 16; i += nt_) ((u32x4*)(F.ws + WS_SPO))[i] = nanv;
        xcd_barrier(xbar); }
#endif
    if (ph == 0) { { BUILD_FRAME(); if (PHMASK & 128) phase_prologue(F); }
#if (REP_MASK >> 7) & 1
        __syncthreads(); { BUILD_FRAME(); phase_prologue(F); }
#endif
        ++ph; __syncthreads(); }
    int did_rep = 0;
    const int ph_end = ph_hi < N_PHASES - 1 ? ph_hi : N_PHASES - 1;
#pragma unroll 1
    for (; ph < ph_end; ++ph) {
        if (ph > ph_lo) xcd_barrier(xbar);
        BUILD_FRAME();
        const int l = (ph - 1) / 7, s = (ph - 1) % 7;
        const bf16_t* wl = (const bf16_t*)(ws + WS_W + (size_t)l * WL_SIZE);
        float* ssl = F.SS + (size_t)(4 * l) * MP * 32; constexpr size_t SSA = (size_t)MP * 32;
        LAS float* tab0 = (LAS float*)(F.lds + pg8::STAGE_BYTES); LAS float* tab1 = tab0 + 2048;
        if (s == 0) { if (PHMASK & 1) {
            pg8::Gemm g{F.XB, wl + WL_IN / 2, MP, DIN, DM}; pg8::StaticOrder S; S.init(MP, DIN, F.G, (int)F.bid);
            prep_rs(S, tab0, ssl, 8, 1.0f / 2048.0f, F.tid);
            pg8::EpiIn E{F.Z, DIN, tab0};
            pg8::gemm_phase<pg8::EpiIn, pg8::StaticOrder, true, true>(F.lds, g, S, E, F.tid);
            if (PRO_LAYERS < DEPTH && l + 1 >= PRO_LAYERS && l + 1 < DEPTH) { int n2 = S.nwg - F.G; if (n2 < 0 || n2 >= F.G) n2 = 0;
                if (F.bid >= n2) { __syncthreads(); convert_weights(F, l + 1, l + 2, (F.bid - n2) * NWAVES + F.wave, (F.G - n2) * NWAVES); } } }
        } else if (s == 1) {
            if (PHMASK & 2) phase_attention(F, l); __syncthreads(); if (PHMASK & 512) {
#ifdef SCAN_OLD_A
 phase_scan_a_old(F, l);
#else
 phase_scan_a(F, l);
#endif
 }
        } else if (s == 2) {
            {
#ifdef SCAN_OLD_C
 phase_scan_c_old(F, l);
#else
 phase_scan_c(F, l);
#endif
 }
        } else if (s == 3) { if (PHMASK & 8) {
            pg8::Gemm g{F.ZS, wl + WL_GLU / 2, MP, SW, SW}; pg8::StaticOrder S; S.init(MP, SW, F.G, (int)F.bid);
            pg8::EpiGlu E{F.ZS, SW, F.CAT + AW, DM, ssl + 2 * SSA};
            pg8::gemm_phase<pg8::EpiGlu, pg8::StaticOrder, true, true>(F.lds, g, S, E, F.tid);
 }
        } else if (s == 4) { if (PHMASK & 16) {
            pg8::Gemm g{F.CAT, wl + WL_OUT / 2, MPR, DM, DM}; pg8::StaticOrder S; S.init(MPR, DM, F.G, (int)F.bid);
            prep_rs(S, tab0, ssl + 1 * SSA, 4, 1.0f / 1024.0f, F.tid); prep_rs(S, tab1, ssl + 2 * SSA, 4, 1.0f / 1024.0f, F.tid);
            for (int i = F.tid; i < 2048; i += NTHR) tab0[i] = tab0[i] / tab1[i];
            __syncthreads();
            pg8::EpiRes<true> E{F.XF, F.XB, DM, ssl + 3 * SSA, tab0, tab1, AW / pg8::BK};
            pg8::gemm_phase<pg8::EpiRes<true>, pg8::StaticOrder, true, true>(F.lds, g, S, E, F.tid); __syncthreads();
            skinny_res(F, F.CAT, DM, wl + WL_OUT / 2, ssl + 3 * SSA, ssl + 1 * SSA, ssl + 2 * SSA, true); }
        } else if (s == 5) { if (PHMASK & 32) {
            pg8::Gemm g{F.XB, wl + WL_GU / 2, MP, 2 * DFF, DM}; pg8::StaticOrder S; S.init(MP, 2 * DFF, F.G, (int)F.bid);
            prep_rs(S, tab0, ssl + 3 * SSA, 8, 1.0f / 2048.0f, F.tid);
            pg8::EpiGU E{F.H, DFF, tab0};
            pg8::gemm_phase<pg8::EpiGU, pg8::StaticOrder, true, true>(F.lds, g, S, E, F.tid);
 }
        } else { if (PHMASK & 64) {
            pg8::Gemm g{F.H, wl + WL_DN / 2, MPR, DM, DFF}; pg8::StaticOrder S; S.init(MPR, DM, F.G, (int)F.bid);
            pg8::EpiRes<false> E{F.XF, F.XB, DM, ssl + 4 * SSA, (LAS float*)nullptr, (LAS float*)nullptr, -1};
            pg8::gemm_phase<pg8::EpiRes<false>, pg8::StaticOrder, true, true>(F.lds, g, S, E, F.tid); __syncthreads();
            skinny_res(F, F.H, DFF, wl + WL_DN / 2, ssl + 4 * SSA, nullptr, nullptr, false);
 }
        }
        __syncthreads();
        if (REP_MASK & 127) { if (((REP_MASK >> s) & 1) && !did_rep) { did_rep = 1; --ph; } else did_rep = 0; }
    }
#ifdef EXTRA_SYNCS
    for (int xs = 0; xs < EXTRA_SYNCS; ++xs) xcd_barrier(xbar);
#endif
    if (ph_hi == N_PHASES) { if (ph > ph_lo) xcd_barrier(xbar); BUILD_FRAME(); if (PHMASK & 256) phase_final(F); }
}

extern "C" void kernel_launch(void* const* d_in, const int* in_sizes, int n_in, void* d_out, int out_size, void* d_ws, size_t ws_size, hipStream_t stream) {
    static int grid = 0;
    if (grid == 0) {
        if (n_in != N_IN || (size_t)out_size != O_END || ws_size < WS_END) { fprintf(stderr, "kernel_launch: unexpected sizes: n_in %d out %d ws %zu (need %zu)\n", n_in, out_size, ws_size, (size_t)WS_END); grid = -1; return; }
        int dev = 0, cus = 0, per_cu = 0;
        (void)hipGetDevice(&dev); (void)hipDeviceGetAttribute(&cus, hipDeviceAttributeMultiprocessorCount, dev);
        if (hipFuncSetAttribute((const void*)mega_fwd, hipFuncAttributeMaxDynamicSharedMemorySize, LDS_BYTES) != hipSuccess) { fprintf(stderr, "kernel_launch: hipFuncSetAttribute failed\n"); grid = -1; return; }
        if (hipOccupancyMaxActiveBlocksPerMultiprocessor(&per_cu, (const void*)mega_fwd, NTHR, LDS_BYTES) != hipSuccess || per_cu < 1) { fprintf(stderr, "kernel_launch: occupancy query gave %d\n", per_cu); per_cu = 1; }
        (void)hipGetLastError();
        grid = cus * per_cu;
        fprintf(stderr, "kernel_launch: grid %d (cus %d x %d)\n", grid, cus, per_cu);
    }
    if (grid < 0) return;
    if (hipMemsetAsync((char*)d_ws + WS_CTL, 0, CTL_BYTES, stream) != hipSuccess) { fprintf(stderr, "kernel_launch: memset failed\n"); return; }
    Params p{};
    for (int i = 0; i < N_IN; ++i) p.in[i] = (const float*)d_in[i];
    p.out = (float*)d_out; p.ws = (unsigned char*)d_ws;
#if MK_SINGLE
    p.ph_lo = 0; p.ph_hi = N_PHASES;
    void* args[] = {&p};
    const hipError_t e = hipLaunchCooperativeKernel((const void*)mega_fwd, dim3(grid), dim3(NTHR), args, LDS_BYTES, stream);
    if (e != hipSuccess) fprintf(stderr, "kernel_launch: cooperative launch failed: %s (grid %d)\n", hipGetErrorString(e), grid);
#else
    for (int ph = 0; ph < N_PHASES; ++ph) { p.ph_lo = ph; p.ph_hi = ph + 1; hipLaunchKernelGGL(mega_fwd, dim3(grid), dim3(NTHR), LDS_BYTES, stream, p); }
#endif
}
```

```cpp
#include <hip/hip_runtime.h>
#include <hip/hip_cooperative_groups.h>
#include <cstdio>
#include <cstdint>
namespace cg = cooperative_groups;

#define SCAN_OLD 1
#ifndef MK_SINGLE
#define MK_SINGLE 1
#endif

constexpr int DM = 2048, SEQ = 4096, NBATCH = 2, DEPTH = 4, DECB = 32, DECS = 4;
constexpr int AW = 1024, SW = 1024, HD = 64, NKV = 2, WIN = 128, NG = 64, SP = 64;
constexpr int DIN = 2304, DFF = 5632;
constexpr int MPR = NBATCH * SEQ, MSM = DECB * DECS, MT = MPR + MSM, MP = 8448;
constexpr float EPS = 1e-5f;
constexpr int ZQ = 0, ZK = 1024, ZV = 1152, ZU = 1280;

enum { I_XP = 0, I_XS, I_CK, I_CV, I_SRE, I_SIM, I_NMIX, I_WIN, I_SINK, I_ARE, I_AIM, I_LDT, I_BRE, I_BIM, I_CRE, I_CIM, I_D, I_WGLU, I_NATT, I_NSSM, I_WOUT, I_NFFN, I_WG, I_WU, I_WD, I_NFIN, N_IN };

constexpr size_t O_YP = 0, O_YS = O_YP + (size_t)MPR * DM, O_KP = O_YS + (size_t)MSM * DM, O_VP = O_KP + (size_t)DEPTH * NBATCH * WIN * 128,
                 O_HRP = O_VP + (size_t)DEPTH * NBATCH * WIN * 128, O_HIP = O_HRP + (size_t)DEPTH * NBATCH * NG * SP, O_KS = O_HIP + (size_t)DEPTH * NBATCH * NG * SP,
                 O_VS = O_KS + (size_t)DEPTH * DECB * WIN * 128, O_HRS = O_VS + (size_t)DEPTH * DECB * WIN * 128, O_HIS = O_HRS + (size_t)DEPTH * DECB * NG * SP,
                 O_END = O_HIS + (size_t)DEPTH * DECB * NG * SP;

constexpr size_t al256(size_t x) { return (x + 255) & ~(size_t)255; }
constexpr size_t WB_IN = (size_t)DIN * DM * 2, WB_GLU = (size_t)SW * SW * 2, WB_OUT = (size_t)DM * DM * 2, WB_GU = (size_t)2 * DFF * DM * 2, WB_DN = (size_t)DM * DFF * 2;
constexpr size_t WL_IN = 0, WL_GLU = WL_IN + WB_IN, WL_OUT = WL_GLU + WB_GLU, WL_GU = WL_OUT + WB_OUT, WL_DN = WL_GU + WB_GU, WL_SIZE = WL_DN + WB_DN;
constexpr size_t WS_W = 0;
constexpr size_t WS_XF = al256(WS_W + DEPTH * WL_SIZE);
constexpr size_t WS_XB = al256(WS_XF + (size_t)MP * DM * 4);
constexpr size_t WS_Z = al256(WS_XB + (size_t)MP * DM * 2);
constexpr size_t WS_CAT = al256(WS_Z + (size_t)MP * DIN * 2);
constexpr size_t WS_ZS = al256(WS_CAT + (size_t)MP * DM * 2);
constexpr size_t WS_H = al256(WS_ZS + (size_t)MP * SW * 2);
constexpr size_t WS_SS = al256(WS_H + (size_t)MP * DFF * 2);
constexpr int NSS = 17;
constexpr size_t WS_SP = al256(WS_SS + (size_t)NSS * MP * 32 * 4);
constexpr size_t SPL = (size_t)(2 * NG * SP + 2 * NG * SP * 16);
constexpr size_t WS_SC = al256(WS_SP + DEPTH * SPL * 4);
constexpr size_t WS_CTL = al256(WS_SC + (size_t)NBATCH * NG * 32 * SP * 8), CTL_BYTES = 16384;
constexpr size_t SPLO = (size_t)(2 * NG * SP + 2 * NG * SP * 16);
constexpr size_t WS_SPO = WS_CTL + CTL_BYTES;
constexpr size_t WS_END = WS_SPO + DEPTH * SPLO * 4;

#define LAS __attribute__((address_space(3)))
typedef unsigned short bf16_t;
typedef short bf16x8 __attribute__((ext_vector_type(8)));
typedef short s16x4 __attribute__((ext_vector_type(4)));
typedef float f32x4 __attribute__((ext_vector_type(4)));
typedef float f32x16 __attribute__((ext_vector_type(16)));
typedef unsigned u32x4 __attribute__((ext_vector_type(4)));
typedef unsigned u32x2 __attribute__((ext_vector_type(2)));

__device__ __forceinline__ unsigned f2bf(float f) { unsigned u = __builtin_bit_cast(unsigned, f); return (u + 0x7fffu + ((u >> 16) & 1u)) >> 16; }
__device__ __forceinline__ unsigned pk2(float lo, float hi) { return f2bf(lo) | (f2bf(hi) << 16); }
typedef float f32x2v_ __attribute__((ext_vector_type(2)));
typedef __bf16 bf16x2v_ __attribute__((ext_vector_type(2)));
__device__ __forceinline__ unsigned cvt2(float lo, float hi) { const f32x2v_ v = {lo, hi}; return __builtin_bit_cast(unsigned, __builtin_convertvector(v, bf16x2v_)); }
__device__ __forceinline__ float bflo(unsigned w) { return __builtin_bit_cast(float, w << 16); }
__device__ __forceinline__ float bfhi(unsigned w) { return __builtin_bit_cast(float, w & 0xffff0000u); }
__device__ __forceinline__ float bf2f(bf16_t b) { return __builtin_bit_cast(float, (unsigned)b << 16); }
__device__ __forceinline__ float wave_sum(float v) {
#pragma unroll
    for (int o = 1; o < 64; o <<= 1) v += __shfl_xor(v, o);
    return v;
}
namespace pg8 {
#define PG8_LAS __attribute__((address_space(3)))
typedef unsigned short bf16_t;
typedef short bf16x8 __attribute__((ext_vector_type(8)));
typedef float f32x4 __attribute__((ext_vector_type(4)));
typedef unsigned u32x4 __attribute__((ext_vector_type(4)));
constexpr int BM = 256, BK = 64, HALF = 128, HTB = HALF * BK * 2  , STAGE_BYTES = 8 * HTB, NXCD = 8, WGM = 8;

__host__ __device__ __forceinline__ int lds_byte(int r, int c) { const int st = (r >> 4) * 2 + (c >> 5), rr = r & 15, cc = c & 31, ob = rr * 64 + cc * 2; return st * 1024 + (ob ^ (((ob >> 9) & 1) << 5)); }
__host__ __device__ __forceinline__ void stage_rc(int b, int& R, int& C) { const int st = b / 1024, sb = b % 1024, swz = sb ^ (((sb >> 9) & 1) << 5); R = (st >> 1) * 16 + swz / 64; C = (st & 1) * 32 + (swz % 64) / 2; }
__host__ __device__ __forceinline__ int perm32(int rho) { const int n = rho >> 4, i = rho & 15; return 8 * (i >> 2) + 4 * n + (i & 3); }

struct Unit { int pm, pn; };
struct Gemm { const bf16_t* A; const bf16_t* Bt; int M, N, K; };

struct StaticOrder {
    int nM, nN, nwg, G, c;
    __host__ __device__ void init(int M, int N, int G_, int c_) { nM = M / BM; nN = N / BM; nwg = nM * nN; G = G_; c = c_; }
    __host__ __device__ bool next(int i, Unit& u) const {
        const long L = (long)i * G + c; if (L >= nwg) return false;
        int wgid = (int)L; { const int q = nwg / NXCD, r = nwg % NXCD, xcd = wgid % NXCD, off = wgid / NXCD; wgid = (xcd < r ? xcd * (q + 1) : r * (q + 1) + (xcd - r) * q) + off; }
        const int nig = WGM * nN, gid = wgid / nig, fm = gid * WGM, gsz = (nM - fm) < WGM ? (nM - fm) : WGM;
        u.pm = fm + ((wgid % nig) % gsz); u.pn = (wgid % nig) / gsz; return true;
    }
    __device__ __forceinline__ void a_ready(const Unit&) const {}
    __device__ __forceinline__ void done(const Unit&) const {}
};

__device__ __forceinline__ unsigned cvt_pk_bf16(float lo, float hi) { unsigned r; asm volatile("v_cvt_pk_bf16_f32 %0, %1, %2" : "=v"(r) : "v"(lo), "v"(hi)); return r; }
typedef float f32x2 __attribute__((ext_vector_type(2)));
__device__ __forceinline__ float rs_of(const float* ss, int r, float invn) { return rsqrtf(ss[r] * invn + 1e-5f); }

struct EpiIn {
    static constexpr bool PERM = true, AFTER_DRAIN = false, MIDK = false;
    bf16_t* O; int ldc; const LAS float* rst;
    __device__ __forceinline__ void operator()(const f32x4 (&acc)[2][2][4][2], const Unit& u, int ui, int wr, int wc, int fr, int fq) const {
        const int row0 = u.pm * BM + wr * 64 + fr, col0 = u.pn * BM + wc * 32 + 8 * fq, lr0 = (ui & 7) * 256 + wr * 64 + fr;
#pragma unroll
        for (int ai = 0; ai < 2; ++ai)
#pragma unroll
            for (int m = 0; m < 4; ++m) { const int r = row0 + ai * HALF + m * 16; const float rs = rst[lr0 + ai * HALF + m * 16]; bf16_t* rowp = O + (size_t)r * ldc + col0;
#pragma unroll
                for (int bj = 0; bj < 2; ++bj) { const f32x4 v0 = acc[ai][bj][m][0] * rs, v1 = acc[ai][bj][m][1] * rs;
                    u32x4 w; w.x = cvt_pk_bf16(v0[0], v0[1]); w.y = cvt_pk_bf16(v0[2], v0[3]); w.z = cvt_pk_bf16(v1[0], v1[1]); w.w = cvt_pk_bf16(v1[2], v1[3]);
                    *(u32x4*)(rowp + bj * HALF) = w; } }
    }
};
struct EpiGlu {
    static constexpr bool PERM = true, AFTER_DRAIN = false, MIDK = false;
    const bf16_t* ZS; int ldz; bf16_t* O; int ldc; float* ssq;
    __device__ __forceinline__ void operator()(const f32x4 (&acc)[2][2][4][2], const Unit& u, int ui, int wr, int wc, int fr, int fq) const {
        const int row0 = u.pm * BM + wr * 64 + fr, col0 = u.pn * BM + wc * 32 + 8 * fq;
#pragma unroll
        for (int ai = 0; ai < 2; ++ai)
#pragma unroll
            for (int m = 0; m < 4; ++m) { const int r = row0 + ai * HALF + m * 16; float sq = 0.f;
#pragma unroll
                for (int bj = 0; bj < 2; ++bj) { const u32x4 zv = *(const u32x4*)(ZS + (size_t)r * ldz + col0 + bj * HALF);
                    const f32x4 a0 = acc[ai][bj][m][0], a1 = acc[ai][bj][m][1];
                    float z[8] = {bflo(zv.x), bfhi(zv.x), bflo(zv.y), bfhi(zv.y), bflo(zv.z), bfhi(zv.z), bflo(zv.w), bfhi(zv.w)};
                    float g[8] = {a0[0], a0[1], a0[2], a0[3], a1[0], a1[1], a1[2], a1[3]};
#pragma unroll
                    for (int e = 0; e < 8; ++e) { z[e] = z[e] * __builtin_amdgcn_rcpf(1.0f + __expf(-g[e])); sq += z[e] * z[e]; }
                    u32x4 w; w.x = cvt_pk_bf16(z[0], z[1]); w.y = cvt_pk_bf16(z[2], z[3]); w.z = cvt_pk_bf16(z[4], z[5]); w.w = cvt_pk_bf16(z[6], z[7]);
                    *(u32x4*)(O + (size_t)r * ldc + col0 + bj * HALF) = w; }
                sq += __shfl_xor(sq, 16); sq += __shfl_xor(sq, 32);
                if (fq == 0) ssq[(size_t)r * 32 + u.pn * 4 + wc] = sq; }
    }
};
template <bool MID> struct EpiRes {
    static constexpr bool PERM = false, AFTER_DRAIN = false, MIDK = MID;
    float* XF; bf16_t* XB; int ldc; float* ssq; const LAS float* rt; const LAS float* rst; int tmid;
    __device__ __forceinline__ void mid(f32x4 (&acc)[2][2][4][2], int ui, int wr, int fr) const {
        const int row0 = (ui & 7) * 256 + wr * 64 + fr;
#pragma unroll
        for (int ai = 0; ai < 2; ++ai)
#pragma unroll
            for (int m = 0; m < 4; ++m) { const int r = row0 + ai * HALF + m * 16; const float f = rt[r];
#pragma unroll
                for (int bj = 0; bj < 2; ++bj)
#pragma unroll
                    for (int n = 0; n < 2; ++n) acc[ai][bj][m][n] = acc[ai][bj][m][n] * f; }
    }
    __device__ __forceinline__ void operator()(const f32x4 (&acc)[2][2][4][2], const Unit& u, int ui, int wr, int wc, int fr, int fq) const {
        const int row0 = u.pm * BM + wr * 64 + fr, col0 = u.pn * BM + wc * 32 + 4 * fq, lr0 = (ui & 7) * 256 + wr * 64 + fr;
#pragma unroll
        for (int ai = 0; ai < 2; ++ai)
#pragma unroll
            for (int m = 0; m < 4; ++m) { const int r = row0 + ai * HALF + m * 16; const float sc = MID ? rst[lr0 + ai * HALF + m * 16] : 1.0f; float sq = 0.f;
                const size_t off = (size_t)r * ldc + col0;
#pragma unroll
                for (int bj = 0; bj < 2; ++bj)
#pragma unroll
                    for (int n = 0; n < 2; ++n) { const size_t o = off + bj * HALF + n * 16; const f32x4 x = *(const f32x4*)(XF + o) + acc[ai][bj][m][n] * sc;
                        *(f32x4*)(XF + o) = x; sq += (x[0] * x[0] + x[1] * x[1]) + (x[2] * x[2] + x[3] * x[3]);
                        u32x2 w; w.x = cvt_pk_bf16(x[0], x[1]); w.y = cvt_pk_bf16(x[2], x[3]); *(u32x2*)(XB + o) = w; }
                sq += __shfl_xor(sq, 16); sq += __shfl_xor(sq, 32);
                if (fq == 0) ssq[(size_t)r * 32 + u.pn * 4 + wc] = sq; }
    }
};
struct EpiGU {
    static constexpr bool PERM = true, AFTER_DRAIN = false, MIDK = false;
    bf16_t* O; int ldc; const LAS float* rst;
    __device__ __forceinline__ void operator()(const f32x4 (&acc)[2][2][4][2], const Unit& u, int ui, int wr, int wc, int fr, int fq) const {
        const int row0 = u.pm * BM + wr * 64 + fr, col0 = u.pn * HALF + wc * 32 + 8 * fq, lr0 = (ui & 7) * 256 + wr * 64 + fr;
#pragma unroll
        for (int ai = 0; ai < 2; ++ai)
#pragma unroll
            for (int m = 0; m < 4; ++m) { const int r = row0 + ai * HALF + m * 16; const float rs = rst[lr0 + ai * HALF + m * 16];
                float h[8];
#pragma unroll
                for (int n = 0; n < 2; ++n)
#pragma unroll
                    for (int e = 0; e < 4; ++e) { const float g = acc[ai][0][m][n][e] * rs, v = acc[ai][1][m][n][e] * rs; h[n * 4 + e] = (g * __builtin_amdgcn_rcpf(1.0f + __expf(-g))) * v; }
                u32x4 w; w.x = cvt_pk_bf16(h[0], h[1]); w.y = cvt_pk_bf16(h[2], h[3]); w.z = cvt_pk_bf16(h[4], h[5]); w.w = cvt_pk_bf16(h[6], h[7]);
                *(u32x4*)(O + (size_t)r * ldc + col0) = w; }
    }
};
template <class Epi, class Sched, bool ALIGN_EPI = false, bool SP2 = false>
__device__ __forceinline__ void gemm_phase(PG8_LAS unsigned char* lds, const Gemm g, const Sched& S, const Epi& E, const int tid) {
    const int wid = __builtin_amdgcn_readfirstlane(tid >> 6), lane = tid & 63, wr = wid >> 2, wc = wid & 3, fr = lane & 15, fq = lane >> 4;
    const int K = g.K, nt = K / BK;
    unsigned voffA[2], voffB[2];
#pragma unroll
    for (int i = 0; i < 2; ++i) { int R, C; stage_rc(tid * 16 + i * 8192, R, C); const int Rb = Epi::PERM ? ((R & ~31) + perm32(R & 31)) : R;
        voffA[i] = (unsigned)(R * K + C) * 2u; voffB[i] = (unsigned)(Rb * K + C) * 2u; }
    const size_t kstep = (size_t)(BK * 2);
    const size_t hstep = (size_t)HALF * K * 2;
    const size_t tstep = 2 * hstep;
    const unsigned ldsw = (unsigned)wid * 1024u;
    const int aoff = lds_byte(wr * 64 + fr, fq * 8), boff = lds_byte(wc * 32 + fr, fq * 8);
#define PG8_SA(b, h) (((b) * 2 + (h)) * HTB)
#define PG8_SB(b, h) ((4 + (b) * 2 + (h)) * HTB)
#define PG8_STAGE(bufoff, gbase, voff) do { _Pragma("unroll") for (int _i = 0; _i < 2; ++_i) \
        __builtin_amdgcn_global_load_lds((const unsigned*)((const char*)(gbase) + (voff)[_i]), (PG8_LAS unsigned*)(lds + (bufoff) + ldsw + _i * 8192), 16, 0, 0); } while (0)
#define PG8_LDA(dst, b, h) do { _Pragma("unroll") for (int m = 0; m < 4; ++m) _Pragma("unroll") for (int k = 0; k < 2; ++k) dst[m][k] = *(const PG8_LAS bf16x8*)(lds + PG8_SA(b, h) + aoff + m * 2048 + k * 1024); } while (0)
#define PG8_LDB(dst, b, h) do { _Pragma("unroll") for (int n = 0; n < 2; ++n) _Pragma("unroll") for (int k = 0; k < 2; ++k) dst[n][k] = *(const PG8_LAS bf16x8*)(lds + PG8_SB(b, h) + boff + n * 2048 + k * 1024); } while (0)
#define PG8_MMA(ai, bj, At, Bt) do { __builtin_amdgcn_s_setprio(1); _Pragma("unroll") for (int m = 0; m < 4; ++m) _Pragma("unroll") for (int n = 0; n < 2; ++n) _Pragma("unroll") for (int k = 0; k < 2; ++k) \
        acc[ai][bj][m][n] = __builtin_amdgcn_mfma_f32_16x16x32_bf16(Bt[n][k], At[m][k], acc[ai][bj][m][n], 0, 0, 0); __builtin_amdgcn_s_setprio(0); } while (0)
#define PG8_WAIT_V(n) asm volatile("s_waitcnt vmcnt(" #n ")" ::: "memory")
#define PG8_WAIT_L(n) asm volatile("s_waitcnt lgkmcnt(" #n ")" ::: "memory")
#define PG8_BAR __builtin_amdgcn_s_barrier()
#define PG8_SCHED __builtin_amdgcn_sched_barrier(0)
    Unit cur, nxt; int ui = 0;
    if (!S.next(0, cur)) return;
    f32x4 acc[2][2][4][2];
#pragma unroll
    for (int a = 0; a < 2; ++a)
#pragma unroll
        for (int b = 0; b < 2; ++b)
#pragma unroll
            for (int m = 0; m < 4; ++m)
#pragma unroll
                for (int n = 0; n < 2; ++n) acc[a][b][m][n] = (f32x4){0.f, 0.f, 0.f, 0.f};
    bf16x8 At[4][2], B0[2][2], B1[2][2];
    const char* cA = (const char*)g.A + (size_t)cur.pm * tstep; const char* cB = (const char*)g.Bt + (size_t)cur.pn * tstep;
    S.a_ready(cur);
    if constexpr (SP2) {
        PG8_STAGE(PG8_SB(0, 0), cB, voffB); PG8_STAGE(PG8_SB(0, 1), cB + hstep, voffB); PG8_STAGE(PG8_SA(0, 0), cA, voffA); PG8_STAGE(PG8_SA(0, 1), cA + hstep, voffA);
        if (wr == 1) PG8_BAR;
        PG8_WAIT_V(2); PG8_BAR;
        PG8_STAGE(PG8_SB(1, 0), cB + kstep, voffB); PG8_STAGE(PG8_SA(1, 0), cA + kstep, voffA); PG8_STAGE(PG8_SB(1, 1), cB + hstep + kstep, voffB);
        PG8_WAIT_V(6); PG8_BAR;
    } else {
        PG8_STAGE(PG8_SB(0, 0), cB, voffB); PG8_STAGE(PG8_SA(0, 0), cA, voffA); PG8_STAGE(PG8_SB(0, 1), cB + hstep, voffB); PG8_STAGE(PG8_SA(0, 1), cA + hstep, voffA);
        if (wr == 1) PG8_BAR;
        PG8_WAIT_V(4); PG8_BAR;
        PG8_STAGE(PG8_SB(1, 0), cB + kstep, voffB); PG8_STAGE(PG8_SA(1, 0), cA + kstep, voffA); PG8_STAGE(PG8_SB(1, 1), cB + hstep + kstep, voffB);
        PG8_WAIT_V(6); PG8_BAR;
    }
    for (;;) {
        const bool has_next = S.next(ui + 1, nxt);
        const char* nA = has_next ? (const char*)g.A + (size_t)nxt.pm * tstep : cA; const char* nB = has_next ? (const char*)g.Bt + (size_t)nxt.pn * tstep : cB;
        for (int t = 0; t < nt; t += 2) {
            const bool last = (t == nt - 2);
            const char* a1 = cA + (size_t)(t + 1) * kstep;
            const char* a2 = last ? nA : cA + (size_t)(t + 2) * kstep; const char* b2 = last ? nB : cB + (size_t)(t + 2) * kstep;
            const char* a3 = a2 + kstep; const char* b3 = b2 + kstep;
            if (last && has_next) S.a_ready(nxt);
            if constexpr (Epi::MIDK) { if (t == E.tmid) E.mid(acc, ui, wr, fr); }
            if constexpr (SP2) {
            PG8_LDB(B0, 0, 0); PG8_LDB(B1, 0, 1); PG8_SCHED; PG8_LDA(At, 0, 0); PG8_STAGE(PG8_SA(1, 1), a1 + hstep, voffA);
            PG8_WAIT_V(8); PG8_WAIT_L(0); PG8_BAR; PG8_MMA(0, 0, At, B0); PG8_MMA(0, 1, At, B1); PG8_BAR; PG8_SCHED;
            PG8_LDA(At, 0, 1); PG8_STAGE(PG8_SB(0, 0), b2, voffB); PG8_STAGE(PG8_SB(0, 1), b2 + hstep, voffB); PG8_STAGE(PG8_SA(0, 0), a2, voffA);
            PG8_WAIT_V(8); PG8_WAIT_L(0); PG8_BAR; PG8_MMA(1, 0, At, B0); PG8_MMA(1, 1, At, B1); PG8_BAR; PG8_SCHED;
            PG8_LDB(B0, 1, 0); PG8_LDB(B1, 1, 1); PG8_SCHED; PG8_LDA(At, 1, 0); PG8_STAGE(PG8_SA(0, 1), a2 + hstep, voffA);
            PG8_WAIT_V(8); PG8_WAIT_L(0); PG8_BAR; PG8_MMA(0, 0, At, B0); PG8_MMA(0, 1, At, B1); PG8_BAR; PG8_SCHED;
            PG8_LDA(At, 1, 1); PG8_STAGE(PG8_SB(1, 0), b3, voffB); PG8_STAGE(PG8_SB(1, 1), b3 + hstep, voffB); PG8_STAGE(PG8_SA(1, 0), a3, voffA);
            PG8_WAIT_V(8); PG8_WAIT_L(0); PG8_BAR; PG8_MMA(1, 0, At, B0); PG8_MMA(1, 1, At, B1); PG8_BAR; PG8_SCHED;
            } else {
            PG8_LDB(B0, 0, 0); PG8_SCHED; PG8_LDA(At, 0, 0); PG8_STAGE(PG8_SA(1, 1), a1 + hstep, voffA);
            PG8_WAIT_L(8); PG8_BAR; PG8_WAIT_L(0); PG8_MMA(0, 0, At, B0); PG8_BAR; PG8_SCHED;
            PG8_LDB(B1, 0, 1); PG8_STAGE(PG8_SB(0, 0), b2, voffB);
            PG8_BAR; PG8_WAIT_L(0); PG8_MMA(0, 1, At, B1); PG8_BAR;
            PG8_LDA(At, 0, 1); PG8_STAGE(PG8_SA(0, 0), a2, voffA);
            PG8_BAR; PG8_WAIT_L(0); PG8_MMA(1, 0, At, B0); PG8_BAR; PG8_SCHED;
            PG8_STAGE(PG8_SB(0, 1), b2 + hstep, voffB);
            PG8_WAIT_V(6); PG8_BAR; PG8_MMA(1, 1, At, B1); PG8_BAR;
            PG8_LDB(B0, 1, 0); PG8_SCHED; PG8_LDA(At, 1, 0); PG8_STAGE(PG8_SA(0, 1), a2 + hstep, voffA);
            PG8_WAIT_L(8); PG8_BAR; PG8_WAIT_L(0); PG8_MMA(0, 0, At, B0); PG8_BAR; PG8_SCHED;
            PG8_LDB(B1, 1, 1); PG8_STAGE(PG8_SB(1, 0), b3, voffB);
            PG8_BAR; PG8_WAIT_L(0); PG8_MMA(0, 1, At, B1); PG8_BAR;
            PG8_LDA(At, 1, 1); PG8_STAGE(PG8_SA(1, 0), a3, voffA);
            PG8_BAR; PG8_WAIT_L(0); PG8_MMA(1, 0, At, B0); PG8_BAR; PG8_SCHED;
            PG8_STAGE(PG8_SB(1, 1), b3 + hstep, voffB);
            PG8_WAIT_V(6); PG8_BAR; PG8_MMA(1, 1, At, B1); PG8_BAR;
            }
        }
        if constexpr (ALIGN_EPI) { if (wr == 0) PG8_BAR; }
        if constexpr (!Epi::AFTER_DRAIN) { E(acc, cur, ui, wr, wc, fr, fq); S.done(cur); }
        if (!has_next) break;
#pragma unroll
        for (int a = 0; a < 2; ++a)
#pragma unroll
            for (int b = 0; b < 2; ++b)
#pragma unroll
                for (int m = 0; m < 4; ++m)
#pragma unroll
                    for (int n = 0; n < 2; ++n) acc[a][b][m][n] = (f32x4){0.f, 0.f, 0.f, 0.f};
        cur = nxt; cA = nA; cB = nB; ++ui;
        if constexpr (ALIGN_EPI) { if (wr == 1) PG8_BAR; }
    }
    PG8_WAIT_V(0);
    if constexpr (!ALIGN_EPI) { if (wr == 0) PG8_BAR; }
    PG8_BAR;
    if constexpr (Epi::AFTER_DRAIN) { E.fused(acc, cur, wr, wc, fr, fq, lds, wid, lane); S.done(cur); }
#undef PG8_SA
#undef PG8_SB
#undef PG8_STAGE
#undef PG8_LDA
#undef PG8_LDB
#undef PG8_MMA
#undef PG8_WAIT_V
#undef PG8_WAIT_L
#undef PG8_BAR
#undef PG8_SCHED
}
}

#ifndef PRO_LAYERS
#define PRO_LAYERS 1
#endif
#ifndef QUOTA_S0
#define QUOTA_S0 4
#define QUOTA_S3 2
#define QUOTA_S5 4
#endif
#ifdef CVT_CPP
#define CVT_HH(a, b) pk2((a), (b))
#else
#define CVT_HH(a, b) pg8::cvt_pk_bf16((a), (b))
#endif
#ifndef CHK_WHICH
#define CHK_WHICH 2
#endif
#ifdef VM_STRICT
#define VMW0() asm volatile("s_waitcnt vmcnt(0)" ::: "memory")
#define VMW0V(a, b) asm volatile("s_waitcnt vmcnt(0)" : "+v"(a), "+v"(b) :: "memory")
#else
#define VMW0()
#define VMW0V(a, b)
#endif
#ifndef CHK_SAME_IN
#define CHK_SAME_IN 0
#endif
#ifndef REP_MASK
#define REP_MASK 0
#endif
#ifndef PHMASK
#define PHMASK 1023
#endif
constexpr int NWAVES = 8, NTHR = 512;
constexpr int LDS_BYTES = 147456 + 256, MISC_OFF = 147456;
constexpr int SCAN_WAVE_BYTES = 17408, HB_STRIDE = 132;
constexpr int KS_STRIDE = 144, VT_STRIDE = 400, ATT_V_OFF = 192 * KS_STRIDE;
constexpr int N_PHASES = 2 + 7 * DEPTH;

#define CAS __attribute__((address_space(4)))
typedef const float* cfp;
struct Params { const float* in[N_IN]; float* out; unsigned char* ws; int ph_lo, ph_hi; };

struct Frame {
    LAS unsigned char* lds; int tid, lane, wave, G, bid;
    const CAS cfp* in; float* out; unsigned char* ws;
    float* XF; bf16_t* XB; bf16_t* Z; bf16_t* CAT; bf16_t* ZS; bf16_t* H; float* SS; float* SPp; float* SC; float* SPo;
};
#define LDS_WAIT() asm volatile("s_waitcnt lgkmcnt(0)" ::: "memory")

__device__ __forceinline__ void p0_transpose_item(const float* W, int K, int N, bf16_t* WT, int item, const float* g1, const float* g2, int split, int mode, LAS float* scr, int lane) {
    const int nblk = N >> 6, kb = item / nblk, nb = item - kb * nblk, k0 = 64 * kb, n0 = 64 * nb;
    const int rr = lane >> 4, cc = (lane & 15) * 4;
    f32x4 v[16];
#pragma unroll
    for (int i = 0; i < 16; ++i) v[i] = __builtin_nontemporal_load((const f32x4*)(W + (size_t)(k0 + 4 * i + rr) * N + n0 + cc));
#pragma unroll
    for (int i = 0; i < 16; ++i) { const int k = k0 + 4 * i + rr; const float g = g1 ? ((k < split) ? g1[k] : g2[k - split]) : 1.0f;
        LAS float* d = scr + (4 * i + rr) * 65 + cc; d[0] = v[i][0] * g; d[1] = v[i][1] * g; d[2] = v[i][2] * g; d[3] = v[i][3] * g; }
    LDS_WAIT();
    const int c = lane & 7;
#pragma unroll
    for (int j = 0; j < 8; ++j) { const int n = (lane >> 3) + 8 * j; const LAS float* s = scr + (8 * c) * 65 + n;
        u32x4 o; o.x = pg8::cvt_pk_bf16(s[0 * 65], s[1 * 65]); o.y = pg8::cvt_pk_bf16(s[2 * 65], s[3 * 65]); o.z = pg8::cvt_pk_bf16(s[4 * 65], s[5 * 65]); o.w = pg8::cvt_pk_bf16(s[6 * 65], s[7 * 65]);
        const int nn = n0 + n; const int drow = (mode == 0) ? nn : (((nn >> 7) << 8) + (nn & 127) + (mode == 2 ? 128 : 0));
        *(u32x4*)(WT + (size_t)drow * K + k0 + 8 * c) = o; }
    LDS_WAIT();
}
constexpr int IT_IN = (DM / 64) * (DIN / 64), IT_GLU = (SW / 64) * (SW / 64), IT_OUT = (DM / 64) * (DM / 64), IT_G = (DM / 64) * (DFF / 64), IT_D = (DFF / 64) * (DM / 64);
constexpr int IT_L = IT_IN + IT_GLU + IT_OUT + 2 * IT_G + IT_D;
__device__ __forceinline__ void convert_item(Frame& F, int l, int r) {
    LAS float* scr = (LAS float*)(F.lds + F.wave * 16640);
    bf16_t* wl = (bf16_t*)(F.ws + WS_W + (size_t)l * WL_SIZE);
    const float* W; const float* g1 = nullptr; const float* g2 = nullptr; bf16_t* WT; int K, N, split = 0, mode = 0;
    if (r < IT_IN) { W = F.in[I_WIN] + (size_t)l * DM * DIN; K = DM; N = DIN; WT = wl + WL_IN / 2; g1 = F.in[I_NMIX] + l * DM; split = DM; }
    else if ((r -= IT_IN) < IT_GLU) { W = F.in[I_WGLU] + (size_t)l * SW * SW; K = SW; N = SW; WT = wl + WL_GLU / 2; }
    else if ((r -= IT_GLU) < IT_OUT) { W = F.in[I_WOUT] + (size_t)l * DM * DM; K = DM; N = DM; WT = wl + WL_OUT / 2; g1 = F.in[I_NATT] + l * AW; g2 = F.in[I_NSSM] + l * SW; split = AW; }
    else if ((r -= IT_OUT) < IT_G) { W = F.in[I_WG] + (size_t)l * DM * DFF; K = DM; N = DFF; WT = wl + WL_GU / 2; g1 = F.in[I_NFFN] + l * DM; split = DM; mode = 1; }
    else if ((r -= IT_G) < IT_G) { W = F.in[I_WU] + (size_t)l * DM * DFF; K = DM; N = DFF; WT = wl + WL_GU / 2; g1 = F.in[I_NFFN] + l * DM; split = DM; mode = 2; }
    else { r -= IT_G; W = F.in[I_WD] + (size_t)l * DFF * DM; K = DFF; N = DM; WT = wl + WL_DN / 2; }
    p0_transpose_item(W, K, N, WT, r, g1, g2, split, mode, scr, F.lane);
}
__device__ __forceinline__ void convert_weights(Frame& F, int l_lo, int l_hi, int gw, int NGW) {
#pragma unroll 1
    for (int it = l_lo * IT_L + gw; it < l_hi * IT_L; it += NGW) convert_item(F, it / IT_L, it % IT_L);
}
__device__ __forceinline__ void convert_steal(Frame& F, int l, int quota) {
    if (l < PRO_LAYERS || l >= DEPTH) return;
    unsigned* ctr = (unsigned*)(F.ws + WS_CTL) + 3584 + 64 * l;
#pragma unroll 1
    for (int q = 0; q < quota; ++q) {
        unsigned it = 0; if (F.lane == 0) it = __hip_atomic_fetch_add(ctr, 1u, __ATOMIC_RELAXED, __HIP_MEMORY_SCOPE_AGENT);
        it = (unsigned)__builtin_amdgcn_readfirstlane((int)it);
        if (it >= (unsigned)IT_L) break;
        convert_item(F, l, (int)it);
    }
}
__device__ __forceinline__ void phase_prologue(Frame& F) {
    const int gw = F.bid * NWAVES + F.wave, NGW = F.G * NWAVES;
#ifdef NAN_POISON
    { const size_t t0_ = (size_t)F.bid * NTHR + F.tid, nt_ = (size_t)F.G * NTHR; const u32x4 nanv = (u32x4){0xffffffffu, 0xffffffffu, 0xffffffffu, 0xffffffffu};
      if (NAN_POISON & 1) for (size_t i = t0_; i < (WS_CAT - WS_Z) / 16; i += nt_) ((u32x4*)(F.ws + WS_Z))[i] = nanv;
      if (NAN_POISON & 2) for (size_t i = t0_; i < (WS_ZS - WS_CAT) / 16; i += nt_) ((u32x4*)(F.ws + WS_CAT))[i] = nanv;
      if (NAN_POISON & 4) for (size_t i = t0_; i < (WS_H - WS_ZS) / 16; i += nt_) ((u32x4*)(F.ws + WS_ZS))[i] = nanv;
      if (NAN_POISON & 8) for (size_t i = t0_; i < (WS_SS - WS_H) / 16; i += nt_) ((u32x4*)(F.ws + WS_H))[i] = nanv;
      if (NAN_POISON & 16) for (size_t i = t0_; i < (WS_CTL - WS_SC) / 16; i += nt_) ((u32x4*)(F.ws + WS_SC))[i] = nanv;
      if (NAN_POISON & 32) for (size_t i = t0_; i < ((size_t)(NSS - 1) * MP * 32 * 4) / 16; i += nt_) ((u32x4*)(F.ws + WS_SS + (size_t)MP * 32 * 4))[i] = nanv; }
#endif
    convert_weights(F, 0, PRO_LAYERS, gw, NGW);
    for (int m = gw; m < MP; m += NGW) {
        f32x4* xf = (f32x4*)(F.XF + (size_t)m * DM) + F.lane; u32x2* xb = (u32x2*)(F.XB + (size_t)m * DM) + F.lane;
        if (m < MT) {
            const f32x4* src = (const f32x4*)(m < MPR ? F.in[I_XP] + (size_t)m * DM : F.in[I_XS] + (size_t)(m - MPR) * DM) + F.lane;
            float s = 0.f;
#pragma unroll
            for (int j = 0; j < 8; ++j) { const f32x4 v = src[64 * j]; s += (v[0] * v[0] + v[1] * v[1]) + (v[2] * v[2] + v[3] * v[3]); xf[64 * j] = v; u32x2 w; w.x = pg8::cvt_pk_bf16(v[0], v[1]); w.y = pg8::cvt_pk_bf16(v[2], v[3]); xb[64 * j] = w; }
            s = wave_sum(s); if (F.lane < 32) F.SS[(size_t)m * 32 + F.lane] = (F.lane == 0) ? s : 0.f;
        } else {
#pragma unroll
            for (int j = 0; j < 8; ++j) { xf[64 * j] = (f32x4){0.f, 0.f, 0.f, 0.f}; xb[64 * j] = (u32x2){0u, 0u}; }
            if (F.lane < 32) F.SS[(size_t)m * 32 + F.lane] = 0.f;
        }
    }
    const int gt = F.bid * NTHR + F.tid, NGT = F.G * NTHR;
    for (int i = gt; i < DEPTH * NG * SP; i += NGT) {
        const int l = i / (NG * SP), gp = i % (NG * SP), g = gp / SP;
        const double dt = exp((double)F.in[I_LDT][l * NG + g]), lr = F.in[I_ARE][i], li = F.in[I_AIM][i];
        const double mag = exp(lr * dt), ang = li * dt, abr = mag * cos(ang), abi = mag * sin(ang), nr = abr - 1.0, den = lr * lr + li * li;
        const double cr = (nr * lr + abi * li) / den, ci = (abi * lr - nr * li) / den;
        float* sp = F.SPp + (size_t)l * SPL;
        sp[gp] = (float)abr; sp[NG * SP + gp] = (float)abi;
#ifdef SCAN_OLD
        { float* so = F.SPo + (size_t)l * SPLO; so[gp] = (float)abr; so[NG * SP + gp] = (float)abi;
          for (int c = 0; c < 16; ++c) { const double br = F.in[I_BRE][(size_t)i * 16 + c], bi = F.in[I_BIM][(size_t)i * 16 + c]; so[2 * NG * SP + gp * 16 + c] = (float)(cr * br - ci * bi); so[2 * NG * SP + NG * SP * 16 + gp * 16 + c] = (float)(cr * bi + ci * br); } }
#endif
        const float* bre = F.in[I_BRE] + (size_t)i * 16; const float* bim = F.in[I_BIM] + (size_t)i * 16;
        const int p = gp % SP;
        bf16_t* bbh = (bf16_t*)(sp + 2 * NG * SP) + (size_t)g * 4 * 512 + (p >> 5) * 512 + (p & 31) * 16;
        unsigned wr_[8], wi_[8];
#pragma unroll
        for (int c = 0; c < 16; c += 2) { const double br0 = bre[c], bi0 = bim[c], br1 = bre[c + 1], bi1 = bim[c + 1];
            wr_[c >> 1] = pk2((float)(cr * br0 - ci * bi0), (float)(cr * br1 - ci * bi1)); wi_[c >> 1] = pk2((float)(cr * bi0 + ci * br0), (float)(cr * bi1 + ci * br1)); }
        *(u32x4*)(bbh) = (u32x4){wr_[0], wr_[1], wr_[2], wr_[3]}; *(u32x4*)(bbh + 8) = (u32x4){wr_[4], wr_[5], wr_[6], wr_[7]};
        *(u32x4*)(bbh + 2 * 512) = (u32x4){wi_[0], wi_[1], wi_[2], wi_[3]}; *(u32x4*)(bbh + 2 * 512 + 8) = (u32x4){wi_[4], wi_[5], wi_[6], wi_[7]};
    }
    for (int i = gt; i < DEPTH * NG * 16 * 64; i += NGT) {
        const int l = i / (NG * 16 * 64), rem = i % (NG * 16 * 64);
        bf16_t* cch = (bf16_t*)(F.SPp + (size_t)l * SPL + 2 * NG * SP + NG * SP * 16);
        ((unsigned*)cch)[rem] = pk2(F.in[I_CRE][i], -F.in[I_CIM][i]);
    }
}

#define MFMA32(a, b, c) __builtin_amdgcn_mfma_f32_32x32x16_bf16((a), (b), (c), 0, 0, 0)
__device__ __forceinline__ int crow(int r, int h) { return (r & 3) + 8 * (r >> 2) + 4 * h; }
__device__ __forceinline__ void attn_wave(const bf16_t* qrow, LAS const unsigned char* ks, LAS const unsigned char* vt, int lo, int hi, float sinkv, bf16_t* orow, float* ssp, int lane) {
    const int n = lane & 31, h = lane >> 5;
    bf16x8 qf[4];
#pragma unroll
    for (int kk = 0; kk < 4; ++kk) qf[kk] = *(const bf16x8*)(qrow + 16 * kk + 8 * h);
    f32x16 st[5];
#pragma unroll
    for (int kt = 0; kt < 5; ++kt) {
#pragma unroll
        for (int i = 0; i < 16; ++i) st[kt][i] = 0.f;
        asm volatile("" : "+v"(st[kt]));
#pragma unroll
        for (int kk = 0; kk < 4; ++kk) { const bf16x8 kf = *(LAS const bf16x8*)(ks + (32 * kt + n) * KS_STRIDE + (16 * kk + 8 * h) * 2); st[kt] = MFMA32(kf, qf[kk], st[kt]); }
        __builtin_amdgcn_sched_barrier(0);
    }
    float mx = -INFINITY;
#pragma unroll
    for (int kt = 0; kt < 5; ++kt)
#pragma unroll
        for (int i = 0; i < 16; ++i) { const int jj = 32 * kt + crow(i, h); const bool ok = (jj >= lo) && (jj <= hi); const float s = ok ? st[kt][i] * 0.125f : -INFINITY; st[kt][i] = s; mx = fmaxf(mx, s); }
    mx = fmaxf(mx, __shfl_xor(mx, 32)); mx = fmaxf(mx, sinkv);
    float sum = 0.f;
#pragma unroll
    for (int kt = 0; kt < 5; ++kt)
#pragma unroll
        for (int i = 0; i < 16; ++i) { const float p = __expf(st[kt][i] - mx); st[kt][i] = p; sum += p; }
    sum += __shfl_xor(sum, 32);
    const float inv = 1.0f / (sum + __expf(sinkv - mx));
    f32x16 o[2];
#pragma unroll
    for (int i = 0; i < 16; ++i) { o[0][i] = 0.f; o[1][i] = 0.f; }
    asm volatile("" : "+v"(o[0]), "+v"(o[1]));
#pragma unroll
    for (int kt = 0; kt < 5; ++kt)
#pragma unroll
        for (int s = 0; s < 2; ++s) {
            u32x4 pw; pw.x = cvt2(st[kt][8 * s + 0], st[kt][8 * s + 1]); pw.y = cvt2(st[kt][8 * s + 2], st[kt][8 * s + 3]); pw.z = cvt2(st[kt][8 * s + 4], st[kt][8 * s + 5]); pw.w = cvt2(st[kt][8 * s + 6], st[kt][8 * s + 7]);
            const bf16x8 pb = __builtin_bit_cast(bf16x8, pw);
#pragma unroll
            for (int dt = 0; dt < 2; ++dt) { LAS const unsigned char* vp = vt + (32 * dt + n) * VT_STRIDE + (32 * kt + 16 * s + 4 * h) * 2;
                const u32x2 a0 = *(LAS const u32x2*)vp, a1 = *(LAS const u32x2*)(vp + 16); u32x4 aw; aw.x = a0.x; aw.y = a0.y; aw.z = a1.x; aw.w = a1.y;
                o[dt] = MFMA32(__builtin_bit_cast(bf16x8, aw), pb, o[dt]); }
            __builtin_amdgcn_sched_barrier(0);
        }
    float sq = 0.f;
#pragma unroll
    for (int dt = 0; dt < 2; ++dt)
#pragma unroll
        for (int ig = 0; ig < 4; ++ig) { const float v0 = o[dt][4 * ig] * inv, v1 = o[dt][4 * ig + 1] * inv, v2 = o[dt][4 * ig + 2] * inv, v3 = o[dt][4 * ig + 3] * inv;
            sq += (v0 * v0 + v1 * v1) + (v2 * v2 + v3 * v3); u32x2 w; w.x = cvt2(v0, v1); w.y = cvt2(v2, v3); *(u32x2*)(orow + 32 * dt + 8 * ig + 4 * h) = w; }
    sq += __shfl_xor(sq, 32);
    if (h == 0) *ssp = sq;
}
__device__ __forceinline__ void vt_scatter(LAS unsigned char* lds, int row, int c8, u32x4 vv) {
    LAS bf16_t* vb = (LAS bf16_t*)(lds + ATT_V_OFF + (8 * c8) * VT_STRIDE + row * 2);
    vb[0 * (VT_STRIDE / 2)] = (bf16_t)(vv.x & 0xffffu); vb[1 * (VT_STRIDE / 2)] = (bf16_t)(vv.x >> 16); vb[2 * (VT_STRIDE / 2)] = (bf16_t)(vv.y & 0xffffu); vb[3 * (VT_STRIDE / 2)] = (bf16_t)(vv.y >> 16);
    vb[4 * (VT_STRIDE / 2)] = (bf16_t)(vv.z & 0xffffu); vb[5 * (VT_STRIDE / 2)] = (bf16_t)(vv.z >> 16); vb[6 * (VT_STRIDE / 2)] = (bf16_t)(vv.w & 0xffffu); vb[7 * (VT_STRIDE / 2)] = (bf16_t)(vv.w >> 16);
}
__device__ __forceinline__ void phase_attention(Frame& F, int l) {
    const bf16_t* Z = F.Z; float* ss_attn = F.SS + (size_t)(4 * l + 1) * MP * 32;
    const float* sink = F.in[I_SINK] + l * 16;
    for (int unit = F.bid; unit < 256 + 2 * DECB; unit += F.G) {
        __syncthreads();
        if (unit < 256) {
            const int b = unit >> 7, nb = (unit >> 2) & 31, kvh = (unit >> 1) & 1, qh = unit & 1;
            const int t0 = 128 * (nb - 1) + 64 * qh;
            for (int ch = F.tid; ch < 192 * 8; ch += NTHR) { const int row = ch >> 3, c8 = ch & 7, pos = t0 + row;
                u32x4 kv = (u32x4){0u, 0u, 0u, 0u}, vv = kv;
                if (pos >= 0) { const bf16_t* zr = Z + (size_t)(b * SEQ + pos) * DIN + kvh * 64 + 8 * c8; kv = *(const u32x4*)(zr + ZK); vv = *(const u32x4*)(zr + ZV); }
                *(LAS u32x4*)(F.lds + row * KS_STRIDE + c8 * 16) = kv; vt_scatter(F.lds, row, c8, vv); }
            if (nb == 31 && qh == 1) {
                for (int idx = F.tid; idx < 128 * 16; idx += NTHR) { const int w = idx >> 4, c = idx & 15; const bf16_t* zr = Z + (size_t)(b * SEQ + SEQ - WIN + w) * DIN + kvh * 64 + 4 * c;
                    const u32x2 kk = *(const u32x2*)(zr + ZK), vv = *(const u32x2*)(zr + ZV); const size_t oo = ((((size_t)l * NBATCH + b) * WIN + w) * NKV + kvh) * HD + 4 * c;
                    *(f32x4*)(F.out + O_KP + oo) = (f32x4){bflo(kk.x), bfhi(kk.x), bflo(kk.y), bfhi(kk.y)}; *(f32x4*)(F.out + O_VP + oo) = (f32x4){bflo(vv.x), bfhi(vv.x), bflo(vv.y), bfhi(vv.y)}; }
            }
            __syncthreads();
            const int n = F.lane & 31, head = kvh * 8 + F.wave;
#pragma unroll 1
            for (int sb = 0; sb < 2; ++sb) { const int s = 2 * qh + sb; const int row = b * SEQ + nb * 128 + 32 * s + n;
                int lo = n + 1; if (nb == 0) lo = max(lo, 128 - 32 * s);
                attn_wave(Z + (size_t)row * DIN + ZQ + head * 64, F.lds + 32 * sb * KS_STRIDE, F.lds + ATT_V_OFF + 32 * sb * 2, lo, n + 128, sink[head], F.CAT + (size_t)row * DM + head * 64, ss_attn + (size_t)row * 32 + head, F.lane); }
        } else {
            const int u2 = unit - 256, b = u2 >> 1, kvh = u2 & 1;
            for (int ch = F.tid; ch < 160 * 8; ch += NTHR) { const int row = ch >> 3, c8 = ch & 7;
                u32x4 kv = (u32x4){0u, 0u, 0u, 0u}, vv = kv;
                if (row < 128) { const size_t ci = ((((size_t)l * DECB + b) * WIN + row) * NKV + kvh) * HD + 8 * c8;
                    const f32x4 k0 = *(const f32x4*)(F.in[I_CK] + ci), k1 = *(const f32x4*)(F.in[I_CK] + ci + 4), v0 = *(const f32x4*)(F.in[I_CV] + ci), v1 = *(const f32x4*)(F.in[I_CV] + ci + 4);
                    kv.x = pk2(k0[0], k0[1]); kv.y = pk2(k0[2], k0[3]); kv.z = pk2(k1[0], k1[1]); kv.w = pk2(k1[2], k1[3]);
                    vv.x = pk2(v0[0], v0[1]); vv.y = pk2(v0[2], v0[3]); vv.z = pk2(v1[0], v1[1]); vv.w = pk2(v1[2], v1[3]);
                    if (row >= DECS) { const size_t oo = ((((size_t)l * DECB + b) * WIN + (row - DECS)) * NKV + kvh) * HD + 8 * c8;
                        *(f32x4*)(F.out + O_KS + oo) = k0; *(f32x4*)(F.out + O_KS + oo + 4) = k1; *(f32x4*)(F.out + O_VS + oo) = v0; *(f32x4*)(F.out + O_VS + oo + 4) = v1; }
                } else if (row < 128 + DECS) { const bf16_t* zr = Z + (size_t)(MPR + DECS * b + (row - 128)) * DIN + kvh * 64 + 8 * c8; kv = *(const u32x4*)(zr + ZK); vv = *(const u32x4*)(zr + ZV);
                    const size_t oo = ((((size_t)l * DECB + b) * WIN + (row - DECS)) * NKV + kvh) * HD + 8 * c8;
                    *(f32x4*)(F.out + O_KS + oo) = (f32x4){bflo(kv.x), bfhi(kv.x), bflo(kv.y), bfhi(kv.y)}; *(f32x4*)(F.out + O_KS + oo + 4) = (f32x4){bflo(kv.z), bfhi(kv.z), bflo(kv.w), bfhi(kv.w)};
                    *(f32x4*)(F.out + O_VS + oo) = (f32x4){bflo(vv.x), bfhi(vv.x), bflo(vv.y), bfhi(vv.y)}; *(f32x4*)(F.out + O_VS + oo + 4) = (f32x4){bflo(vv.z), bfhi(vv.z), bflo(vv.w), bfhi(vv.w)}; }
                *(LAS u32x4*)(F.lds + row * KS_STRIDE + c8 * 16) = kv; vt_scatter(F.lds, row, c8, vv); }
            __syncthreads();
            if (F.wave == 0) { const int n = F.lane & 31, t = n & 3, head = kvh * 8 + (n >> 2), row = MPR + DECS * b + t;
                attn_wave(Z + (size_t)row * DIN + ZQ + head * 64, F.lds, F.lds + ATT_V_OFF, t + 1, t + 128, sink[head], F.CAT + (size_t)row * DM + head * 64, ss_attn + (size_t)row * 32 + head, F.lane); }
        }
    }
}

__device__ __forceinline__ void wave_lds_sync() { asm volatile("s_waitcnt lgkmcnt(0)" ::: "memory"); __builtin_amdgcn_wave_barrier(); asm volatile("" ::: "memory"); }
__device__ __forceinline__ float gelu_as(float v) {
    const float t = __builtin_amdgcn_rcpf(fmaf(fabsf(v), 0.2316418882f, 1.0f));
    float q = fmaf(t, 0.5307027145f, -0.7265760135f); q = fmaf(q, t, 0.7107068705f); q = fmaf(q, t, -0.142248368f); q = fmaf(q, t, 0.127414796f); q = q * t;
    const float e = __builtin_amdgcn_exp2f((v * v) * (-0.72134752044f));
    const float mm = v * (q * e);
    return v < 0.f ? mm : v - mm;
}
#define SCAN_BU(rowbase) do { \
        const bf16x8 uf_ = *(const bf16x8*)(F.Z + (size_t)((rowbase) + n32) * DIN + ZU + 16 * g + 8 * h2); \
        _Pragma("unroll") for (int nt_ = 0; nt_ < 4; ++nt_) { f32x16 d_; _Pragma("unroll") for (int r = 0; r < 16; ++r) d_[r] = 0.f; asm volatile("" : "+v"(d_)); d_ = MFMA32(uf_, bbf[nt_], d_); asm volatile("s_nop 15\n\ts_nop 15\n\ts_nop 15\n\ts_nop 15" : "+v"(d_)); \
            _Pragma("unroll") for (int r = 0; r < 16; ++r) BU[crow(r, h2) * HB_STRIDE + 32 * nt_ + n32] = d_[r]; } } while (0)
#ifdef PARAM_SC1
#define SCAN_LOAD_PARAMS() \
        bf16x8 bbf[4]; { const unsigned* bbh = (const unsigned*)((const bf16_t*)(sp + 2 * NG * SP) + (size_t)g * 4 * 512 + n32 * 16 + 8 * h2); \
            _Pragma("unroll") for (int nt_ = 0; nt_ < 4; ++nt_) { u32x4 w_; w_.x = __hip_atomic_load(bbh + nt_ * 256 + 0, __ATOMIC_RELAXED, __HIP_MEMORY_SCOPE_AGENT); w_.y = __hip_atomic_load(bbh + nt_ * 256 + 1, __ATOMIC_RELAXED, __HIP_MEMORY_SCOPE_AGENT); \
                w_.z = __hip_atomic_load(bbh + nt_ * 256 + 2, __ATOMIC_RELAXED, __HIP_MEMORY_SCOPE_AGENT); w_.w = __hip_atomic_load(bbh + nt_ * 256 + 3, __ATOMIC_RELAXED, __HIP_MEMORY_SCOPE_AGENT); bbf[nt_] = __builtin_bit_cast(bf16x8, w_); } } \
        const float ar = __hip_atomic_load(sp + g * SP + p, __ATOMIC_RELAXED, __HIP_MEMORY_SCOPE_AGENT), ai = __hip_atomic_load(sp + NG * SP + g * SP + p, __ATOMIC_RELAXED, __HIP_MEMORY_SCOPE_AGENT);
#else
#define SCAN_LOAD_PARAMS() \
        bf16x8 bbf[4]; { const bf16_t* bbh = (const bf16_t*)(sp + 2 * NG * SP) + (size_t)g * 4 * 512 + n32 * 16 + 8 * h2; \
            _Pragma("unroll") for (int nt_ = 0; nt_ < 4; ++nt_) bbf[nt_] = *(const bf16x8*)(bbh + nt_ * 512); } \
        const float ar = sp[g * SP + p], ai = sp[NG * SP + g * SP + p];
#endif

__device__ __forceinline__ void phase_scan_a(Frame& F, int l) {
    LAS float* BU = (LAS float*)(F.lds + F.wave * SCAN_WAVE_BYTES);
    const float* sp = F.SPp + (size_t)l * SPL; const int p = F.lane, n32 = F.lane & 31, h2 = F.lane >> 5;
    const int gw = F.bid * NWAVES + F.wave, NGW = F.G * NWAVES;
    for (int task = gw; task < NBATCH * NG * 31; task += NGW) {
        const int c = task % 31, bg = task / 31, g = bg % NG, b = bg / NG, row0 = b * SEQ + c * 128;
        SCAN_LOAD_PARAMS();
        float hr = 0.f, hi = 0.f;
#pragma unroll 1
        for (int t0 = 0; t0 < 128; t0 += 32) {
            wave_lds_sync();
            SCAN_BU(row0 + t0);
            wave_lds_sync();
#pragma unroll 8
            for (int tt = 0; tt < 32; ++tt) { const float br = BU[tt * HB_STRIDE + p], bi = BU[tt * HB_STRIDE + 64 + p];
                const float nr_ = fmaf(ar, hr, fmaf(-ai, hi, br)), ni_ = fmaf(ar, hi, fmaf(ai, hr, bi)); hr = nr_; hi = ni_; }
        }
        *(float2*)(F.SC + ((size_t)(bg * 32 + c) * SP + p) * 2) = make_float2(hr, hi);
    }
}
__device__ __forceinline__ void phase_scan_c(Frame& F, int l) {
    LAS float* BU = (LAS float*)(F.lds + F.wave * SCAN_WAVE_BYTES);
    const float* sp = F.SPp + (size_t)l * SPL; const int p = F.lane, n32 = F.lane & 31, h2 = F.lane >> 5;
    const int gw = F.bid * NWAVES + F.wave, NGW = F.G * NWAVES;
    constexpr int NPT = NBATCH * NG * 32, NST = DECB * NG;
    for (int task = gw; task < NPT + NST; task += NGW) {
        int c, g, b, row0, T; const bool prompt = task < NPT;
        if (prompt) { c = task % 32; const int bg = task / 32; g = bg % NG; b = bg / NG; row0 = b * SEQ + c * 128; T = 128; }
        else { const int t2 = task - NPT; c = 0; g = t2 % NG; b = t2 / NG; row0 = MPR + DECS * b; T = DECS; }
        SCAN_LOAD_PARAMS();
        unsigned chk0 = 0u, chs0 = 0u;
#ifdef SELFCHECK_C
        int nrep2 = 2; asm volatile("" : "+s"(nrep2));
#pragma unroll 1
        for (int rep2 = 0; rep2 < nrep2; ++rep2) {
#else
        { const int rep2 = 0;
#endif
        unsigned chk = 0u, chs = 0u;
        float hr = 0.f, hi = 0.f;
        if (prompt) {
            float tr = ar, ti = ai;
#pragma unroll
            for (int q = 0; q < 7; ++q) { const float xr = fmaf(tr, tr, -(ti * ti)), xi = (2.f * tr) * ti; tr = xr; ti = xi; }
            const float2* scp = (const float2*)F.SC + (size_t)((b * NG + g) * 32) * SP + p;
            VMW0();
#pragma unroll 1
            for (int j = 0; j < c; ++j) { float2 s = scp[(size_t)j * SP]; VMW0V(s.x, s.y); const float xr = fmaf(tr, hr, fmaf(-ti, hi, s.x)), xi = fmaf(tr, hi, fmaf(ti, hr, s.y)); hr = xr; hi = xi;
#if defined(CHK_SC_ONLY) || defined(CHK_INPUTS)
                chk = chk * 31u + __builtin_bit_cast(unsigned, s.x); chk = chk * 31u + __builtin_bit_cast(unsigned, s.y);
#endif
                chs = chs * 31u + __builtin_bit_cast(unsigned, s.x); chs = chs * 31u + __builtin_bit_cast(unsigned, s.y); chs = chs * 31u + __builtin_bit_cast(unsigned, tr); chs = chs * 31u + __builtin_bit_cast(unsigned, ti);
            }
        } else { const size_t si = (((size_t)l * DECB + b) * NG + g) * SP + p; hr = F.in[I_SRE][si]; hi = F.in[I_SIM][si]; }
#ifdef CHK_INPUTS
        chk = chk * 31u + __builtin_bit_cast(unsigned, ar); chk = chk * 31u + __builtin_bit_cast(unsigned, ai); chk = chk * 31u + __builtin_bit_cast(unsigned, hr); chk = chk * 31u + __builtin_bit_cast(unsigned, hi);
#endif
#ifdef CHK_AR_ONLY
        chk = chk * 31u + __builtin_bit_cast(unsigned, ar); chk = chk * 31u + __builtin_bit_cast(unsigned, ai);
#endif
#ifdef CHK_INIT_ONLY
        chk = chk * 31u + __builtin_bit_cast(unsigned, hr); chk = chk * 31u + __builtin_bit_cast(unsigned, hi);
#endif
        bf16x8 ccf[8];
        { const bf16_t* cch = (const bf16_t*)(sp + 2 * NG * SP + NG * SP * 16) + ((size_t)g * 16 + (n32 & 15)) * 128 + 8 * h2;
#pragma unroll
          for (int s = 0; s < 8; ++s) { bf16x8 v = *(const bf16x8*)(cch + 16 * s); if (n32 >= 16) v = (bf16x8){0, 0, 0, 0, 0, 0, 0, 0}; ccf[s] = v; } }
        f32x4 dv[2];
#pragma unroll
        for (int q = 0; q < 2; ++q) dv[q] = *(const f32x4*)(F.in[I_D] + l * SW + g * 16 + 8 * q + 4 * h2);
#pragma unroll 1
        for (int t0 = 0; t0 < T; t0 += 32) {
            const int nt = min(32, T - t0);
            wave_lds_sync();
            SCAN_BU(row0 + t0);
            wave_lds_sync();
#ifdef BU_VALU
            for (int tt = 0; tt < nt; ++tt) { float br = 0.f, bi = 0.f;
                const u32x4* up = (const u32x4*)(F.Z + (size_t)(row0 + t0 + tt) * DIN + ZU + 16 * g); const u32x4 ua = up[0], ub = up[1];
                {
                  const float uu_[16] = {bflo(ua.x), bfhi(ua.x), bflo(ua.y), bfhi(ua.y), bflo(ua.z), bfhi(ua.z), bflo(ua.w), bfhi(ua.w), bflo(ub.x), bfhi(ub.x), bflo(ub.y), bfhi(ub.y), bflo(ub.z), bfhi(ub.z), bflo(ub.w), bfhi(ub.w)};
                  const bf16_t* bre_ = (const bf16_t*)(sp + 2 * NG * SP) + (size_t)g * 4 * 512 + (p >> 5) * 512 + (p & 31) * 16;
#pragma unroll
                  for (int c_ = 0; c_ < 16; ++c_) { br += bf2f(bre_[c_]) * uu_[c_]; bi += bf2f(bre_[2 * 512 + c_]) * uu_[c_]; } }
#if defined(CHK_U_ONLY) || defined(CHK_INPUTS)
                chk = chk * 31u + ua.x + ua.y * 3u + ua.z * 5u + ua.w * 7u + ub.x * 11u + ub.y * 13u + ub.z * 17u + ub.w * 19u;
#endif
#if defined(CHK_BR_ONLY) || defined(CHK_INPUTS)
                chk = chk * 31u + __builtin_bit_cast(unsigned, br); chk = chk * 31u + __builtin_bit_cast(unsigned, bi);
#endif
#else
            for (int tt = 0; tt < nt; ++tt) { const float br = BU[tt * HB_STRIDE + p], bi = BU[tt * HB_STRIDE + 64 + p];
#endif
#ifdef NO_PK
                float t1_ = fmaf(-ai, hi, br); asm volatile("" : "+v"(t1_)); float t2_ = fmaf(ai, hr, bi); asm volatile("" : "+v"(t2_));
                float nr_ = fmaf(ar, hr, t1_); asm volatile("" : "+v"(nr_)); float ni_ = fmaf(ar, hi, t2_); asm volatile("" : "+v"(ni_)); hr = nr_; hi = ni_;
#else
                const float nr_ = fmaf(ar, hr, fmaf(-ai, hi, br)), ni_ = fmaf(ar, hi, fmaf(ai, hr, bi)); hr = nr_; hi = ni_;
#endif
                BU[tt * HB_STRIDE + p] = __builtin_bit_cast(float, CVT_HH(hr, hi)); }
            wave_lds_sync();
            f32x16 y;
#pragma unroll
            for (int r = 0; r < 16; ++r) y[r] = 0.f;
            asm volatile("" : "+v"(y));
#pragma unroll
            for (int s = 0; s < 8; ++s) { const bf16x8 hf = *(const LAS bf16x8*)((const LAS unsigned char*)BU + n32 * (HB_STRIDE * 4) + 32 * s + 16 * h2); y = MFMA32(ccf[s], hf, y); }
            asm volatile("s_nop 15\n\ts_nop 15\n\ts_nop 15\n\ts_nop 15" : "+v"(y));
            if (n32 < nt) { const size_t row = (size_t)(row0 + t0 + n32);
#pragma unroll
                for (int q = 0; q < 2; ++q) { const int ch0 = 16 * g + 8 * q + 4 * h2; const u32x2 uu = *(const u32x2*)(F.Z + row * DIN + ZU + ch0);
                    const float u4[4] = {bflo(uu.x), bfhi(uu.x), bflo(uu.y), bfhi(uu.y)}; float z4[4];
#pragma unroll
                    for (int e2 = 0; e2 < 4; ++e2) { const float yy = fmaf(dv[q][e2], u4[e2], y[4 * q + e2]); z4[e2] = gelu_as(yy); }
                    u32x2 w; w.x = pg8::cvt_pk_bf16(z4[0], z4[1]); w.y = pg8::cvt_pk_bf16(z4[2], z4[3]);
#ifndef CHK_STATE_ONLY
                    chk = chk * 31u + w.x; chk = chk * 31u + w.y;
#endif
                    if (rep2 == 0) *(u32x2*)(F.ZS + row * SW + ch0) = w; } }
        }
        if (prompt) { if (c == 31) { const size_t oi = (((size_t)l * NBATCH + b) * NG + g) * SP + p; F.out[O_HRP + oi] = hr; F.out[O_HIP + oi] = hi; } }
        else { const size_t oi = (((size_t)l * DECB + b) * NG + g) * SP + p; F.out[O_HRS + oi] = hr; F.out[O_HIS + oi] = hi; }
#if !defined(CHK_SC_ONLY) && !defined(CHK_U_ONLY) && !defined(CHK_BR_ONLY) && !defined(CHK_INPUTS) && !defined(CHK_AR_ONLY) && !defined(CHK_INIT_ONLY)
        chk = chk * 31u + __builtin_bit_cast(unsigned, hr); chk = chk * 31u + __builtin_bit_cast(unsigned, hi);
#endif
        if (rep2 == 0) { chk0 = chk; chs0 = chs; } else if (chk != chk0 && (!CHK_SAME_IN || chs == chs0) && (CHK_WHICH == 2 || (CHK_WHICH == 1) == prompt)) F.ZS[(size_t)row0 * SW + 16 * g + (F.lane & 15)] = (bf16_t)0xffffu;
        }
    }
}
#ifdef SCAN_OLD
__device__ __forceinline__ void scan_load_u(const bf16_t* Z, int row0, int T, int g, LAS float* UB, int lane) {
    for (int ch = lane; ch < 2 * T; ch += 64) { const int tok = ch >> 1, hf = ch & 1; const u32x4 v = *(const u32x4*)(Z + (size_t)(row0 + tok) * DIN + ZU + 16 * g + 8 * hf);
        *(LAS f32x4*)(UB + tok * 16 + 8 * hf) = (f32x4){bflo(v.x), bfhi(v.x), bflo(v.y), bfhi(v.y)}; *(LAS f32x4*)(UB + tok * 16 + 8 * hf + 4) = (f32x4){bflo(v.z), bfhi(v.z), bflo(v.w), bfhi(v.w)}; }
}
#define SCAN_STEP(t) do { const LAS f32x4* up = (const LAS f32x4*)(UB + (t) * 16); const f32x4 u0 = up[0], u1 = up[1], u2 = up[2], u3 = up[3]; \
        float br = 0.f, bi = 0.f; \
        _Pragma("unroll") for (int c = 0; c < 4; ++c) { br += bbr[c] * u0[c]; bi += bbi[c] * u0[c]; } \
        _Pragma("unroll") for (int c = 0; c < 4; ++c) { br += bbr[4 + c] * u1[c]; bi += bbi[4 + c] * u1[c]; } \
        _Pragma("unroll") for (int c = 0; c < 4; ++c) { br += bbr[8 + c] * u2[c]; bi += bbi[8 + c] * u2[c]; } \
        _Pragma("unroll") for (int c = 0; c < 4; ++c) { br += bbr[12 + c] * u3[c]; bi += bbi[12 + c] * u3[c]; } \
        const float nr_ = ar * hr - ai * hi + br, ni_ = ar * hi + ai * hr + bi; hr = nr_; hi = ni_; } while (0)

__device__ __forceinline__ void phase_scan_a_old(Frame& F, int l) {
    LAS float* UB = (LAS float*)(F.lds + F.wave * SCAN_WAVE_BYTES);
    const float* sp = F.SPo + (size_t)l * SPLO; const int p = F.lane;
    const int gw = F.bid * NWAVES + F.wave, NGW = F.G * NWAVES;
    for (int task = gw; task < NBATCH * NG * 31; task += NGW) {
        const int c = task % 31, bg = task / 31, g = bg % NG, b = bg / NG;
        wave_lds_sync();
        scan_load_u(F.Z, b * SEQ + c * 128, 128, g, UB, F.lane);
        float bbr[16], bbi[16];
#pragma unroll
        for (int q = 0; q < 4; ++q) { const f32x4 x = *(const f32x4*)(sp + 2 * NG * SP + (g * SP + p) * 16 + 4 * q), y = *(const f32x4*)(sp + 2 * NG * SP + NG * SP * 16 + (g * SP + p) * 16 + 4 * q);
            bbr[4 * q] = x[0]; bbr[4 * q + 1] = x[1]; bbr[4 * q + 2] = x[2]; bbr[4 * q + 3] = x[3]; bbi[4 * q] = y[0]; bbi[4 * q + 1] = y[1]; bbi[4 * q + 2] = y[2]; bbi[4 * q + 3] = y[3]; }
        const float ar = sp[g * SP + p], ai = sp[NG * SP + g * SP + p];
        float hr = 0.f, hi = 0.f;
        wave_lds_sync();
#pragma unroll 4
        for (int t = 0; t < 128; ++t) SCAN_STEP(t);
        *(float2*)(F.SC + ((size_t)(bg * 32 + c) * SP + p) * 2) = make_float2(hr, hi);
    }
}
__device__ __forceinline__ void phase_scan_c_old(Frame& F, int l) {
    LAS float* UB = (LAS float*)(F.lds + F.wave * SCAN_WAVE_BYTES); LAS float* HB = UB + 2048;
    const float* sp = F.SPo + (size_t)l * SPLO; const int p = F.lane, ch = F.lane & 15, tq = F.lane >> 4;
    const int gw = F.bid * NWAVES + F.wave, NGW = F.G * NWAVES;
    constexpr int NPT = NBATCH * NG * 32, NST = DECB * NG;
    for (int task = gw; task < NPT + NST; task += NGW) {
        int c, g, b, row0, T; const bool prompt = task < NPT;
        if (prompt) { c = task % 32; const int bg = task / 32; g = bg % NG; b = bg / NG; row0 = b * SEQ + c * 128; T = 128; }
        else { const int t2 = task - NPT; c = 0; g = t2 % NG; b = t2 / NG; row0 = MPR + DECS * b; T = DECS; }
        wave_lds_sync();
        scan_load_u(F.Z, row0, T, g, UB, F.lane);
        float bbr[16], bbi[16];
#pragma unroll
        for (int q = 0; q < 4; ++q) { const f32x4 x = *(const f32x4*)(sp + 2 * NG * SP + (g * SP + p) * 16 + 4 * q), y = *(const f32x4*)(sp + 2 * NG * SP + NG * SP * 16 + (g * SP + p) * 16 + 4 * q);
            bbr[4 * q] = x[0]; bbr[4 * q + 1] = x[1]; bbr[4 * q + 2] = x[2]; bbr[4 * q + 3] = x[3]; bbi[4 * q] = y[0]; bbi[4 * q + 1] = y[1]; bbi[4 * q + 2] = y[2]; bbi[4 * q + 3] = y[3]; }
        const float ar = sp[g * SP + p], ai = sp[NG * SP + g * SP + p];
        float hr = 0.f, hi = 0.f;
        if (prompt) {
            float tr = ar, ti = ai;
#pragma unroll
            for (int q = 0; q < 7; ++q) { const float xr = fmaf(tr, tr, -(ti * ti)), xi = (2.f * tr) * ti; tr = xr; ti = xi; }
            const float2* scp = (const float2*)F.SC + (size_t)((b * NG + g) * 32) * SP + p;
            for (int j = 0; j < c; ++j) { const float2 s = scp[(size_t)j * SP]; const float xr = fmaf(tr, hr, fmaf(-ti, hi, s.x)), xi = fmaf(tr, hi, fmaf(ti, hr, s.y)); hr = xr; hi = xi; }
        } else { const size_t si = (((size_t)l * DECB + b) * NG + g) * SP + p; hr = F.in[I_SRE][si]; hi = F.in[I_SIM][si]; }
        float cre[16], cim[16];
        { const float* cr = F.in[I_CRE] + (((size_t)l * NG + g) * 16 + ch) * SP + 16 * tq; const float* ci = F.in[I_CIM] + (((size_t)l * NG + g) * 16 + ch) * SP + 16 * tq;
#pragma unroll
          for (int q = 0; q < 4; ++q) { const f32x4 x = *(const f32x4*)(cr + 4 * q), y = *(const f32x4*)(ci + 4 * q);
              cre[4 * q] = x[0]; cre[4 * q + 1] = x[1]; cre[4 * q + 2] = x[2]; cre[4 * q + 3] = x[3]; cim[4 * q] = y[0]; cim[4 * q + 1] = y[1]; cim[4 * q + 2] = y[2]; cim[4 * q + 3] = y[3]; } }
        const float dch = F.in[I_D][l * SW + g * 16 + ch];
        wave_lds_sync();
        for (int t0 = 0; t0 < T; t0 += 16) {
            const int nt = min(16, T - t0);
            for (int tt = 0; tt < nt; ++tt) { SCAN_STEP(t0 + tt); HB[tt * HB_STRIDE + p] = hr; HB[tt * HB_STRIDE + 64 + p] = hi; }
            wave_lds_sync();
            float ysel[4] = {0.f, 0.f, 0.f, 0.f};
#pragma unroll
            for (int tt = 0; tt < 16; ++tt) {
                if (tt < nt) { const LAS f32x4* hp = (const LAS f32x4*)(HB + tt * HB_STRIDE + 16 * tq); float y0 = 0.f, y1 = 0.f;
#pragma unroll
                    for (int q = 0; q < 4; ++q) { const f32x4 a = hp[q], bq = hp[16 + q];
                        y0 += a[0] * cre[4 * q] + a[1] * cre[4 * q + 1] + a[2] * cre[4 * q + 2] + a[3] * cre[4 * q + 3];
                        y1 += bq[0] * cim[4 * q] + bq[1] * cim[4 * q + 1] + bq[2] * cim[4 * q + 2] + bq[3] * cim[4 * q + 3]; }
                    float y = y0 - y1; y += __shfl_xor(y, 16); y += __shfl_xor(y, 32);
                    if ((tt & 3) == tq) ysel[tt >> 2] = y; } }
#pragma unroll
            for (int i = 0; i < 4; ++i) { const int tt = 4 * i + tq;
                if (tt < nt) { const float y = ysel[i] + dch * UB[(t0 + tt) * 16 + ch];
                    const float z = 0.5f * y * (1.0f + erff(y * 0.70710678118654752f));
                    F.ZS[(size_t)(row0 + t0 + tt) * SW + g * 16 + ch] = (bf16_t)f2bf(z); } }
            wave_lds_sync();
        }
        if (prompt) { if (c == 31) { const size_t oi = (((size_t)l * NBATCH + b) * NG + g) * SP + p; F.out[O_HRP + oi] = hr; F.out[O_HIP + oi] = hi; } }
        else { const size_t oi = (((size_t)l * DECB + b) * NG + g) * SP + p; F.out[O_HRS + oi] = hr; F.out[O_HIS + oi] = hi; }
    }
}
#endif
__device__ __forceinline__ void phase_final(Frame& F) {
    const int gw = F.bid * NWAVES + F.wave, NGW = F.G * NWAVES; const float* ssf = F.SS + (size_t)16 * MP * 32; const f32x4* gf = (const f32x4*)F.in[I_NFIN] + F.lane;
    for (int m = gw; m < MT; m += NGW) { float sp_ = ssf[(size_t)m * 32 + (F.lane & 31)];
#pragma unroll
        for (int o_ = 1; o_ < 32; o_ <<= 1) sp_ += __shfl_xor(sp_, o_);
        const float rs = rsqrtf(sp_ * (1.0f / DM) + EPS); const f32x4* xf = (const f32x4*)(F.XF + (size_t)m * DM) + F.lane; f32x4* o = (f32x4*)(F.out + O_YP + (size_t)m * DM) + F.lane;
#pragma unroll
        for (int j = 0; j < 8; ++j) o[64 * j] = xf[64 * j] * rs * gf[64 * j]; }
}

__device__ __forceinline__ void skinny_res(Frame& F, const bf16_t* A, int K, const bf16_t* Bt, float* ssq, const float* ssp_a, const float* ssp_s, bool mid) {
    LAS float* red = (LAS float*)F.lds;
    const int i = F.lane & 15, kq = F.lane >> 4, kw = K >> 3;
    for (int item = F.bid; item < 256; item += F.G) {
        const int rb = (item >> 3) & 7, cs = (item & 7) + 8 * (item >> 6), row0 = MPR + 16 * rb, col0 = 64 * cs;
        __syncthreads();
        const bf16_t* ap = A + (size_t)(row0 + i) * K + F.wave * kw + 8 * kq;
        const bf16_t* bp = Bt + (size_t)(col0 + i) * K + F.wave * kw + 8 * kq;
        f32x4 acc[4];
#pragma unroll
        for (int cb = 0; cb < 4; ++cb) acc[cb] = (f32x4){0.f, 0.f, 0.f, 0.f};
#pragma unroll 2
        for (int ks = 0; ks < kw; ks += 32) { const bf16x8 a = *(const bf16x8*)(ap + ks);
#pragma unroll
            for (int cb = 0; cb < 4; ++cb) { const bf16x8 b = *(const bf16x8*)(bp + (size_t)cb * 16 * K + ks); acc[cb] = __builtin_amdgcn_mfma_f32_16x16x32_bf16(b, a, acc[cb], 0, 0, 0); } }
#pragma unroll
        for (int cb = 0; cb < 4; ++cb) *(LAS f32x4*)(red + (F.wave * 16 + i) * 64 + 16 * cb + 4 * kq) = acc[cb];
        __syncthreads();
        if (F.tid < 256) { const int r = F.tid >> 4, c4 = (F.tid & 15) * 4, row = row0 + r;
            f32x4 sa = (f32x4){0.f, 0.f, 0.f, 0.f}, sb = sa;
#pragma unroll
            for (int w = 0; w < 4; ++w) { sa += *(const LAS f32x4*)(red + (w * 16 + r) * 64 + c4); sb += *(const LAS f32x4*)(red + ((w + 4) * 16 + r) * 64 + c4); }
            f32x4 val = sa + sb;
            if (mid) { float pa = 0.f, ps = 0.f; const f32x4* qa = (const f32x4*)(ssp_a + (size_t)row * 32); const f32x4* qs = (const f32x4*)(ssp_s + (size_t)row * 32);
#pragma unroll
                for (int q = 0; q < 4; ++q) { const f32x4 x = qa[q], y = qs[q]; pa += (x[0] + x[1]) + (x[2] + x[3]); ps += (y[0] + y[1]) + (y[2] + y[3]); }
                val = sa * rsqrtf(pa * (1.0f / 1024.0f) + EPS) + sb * rsqrtf(ps * (1.0f / 1024.0f) + EPS); }
            const size_t o = (size_t)row * DM + col0 + c4; const f32x4 x = *(const f32x4*)(F.XF + o) + val;
            *(f32x4*)(F.XF + o) = x; u32x2 wv; wv.x = pk2(x[0], x[1]); wv.y = pk2(x[2], x[3]); *(u32x2*)(F.XB + o) = wv;
            float sq = (x[0] * x[0] + x[1] * x[1]) + (x[2] * x[2] + x[3] * x[3]);
            sq += __shfl_xor(sq, 1); sq += __shfl_xor(sq, 2); sq += __shfl_xor(sq, 4); sq += __shfl_xor(sq, 8);
            if ((F.tid & 15) == 0) ssq[(size_t)row * 32 + cs] = sq; }
    }
    __syncthreads();
}
#define XB_TMO      128
#define XB_XCNT(j)  (256  + 64 * (j))
#define XB_XSUB(j)  (1280 + 64 * (j))
#define XB_XGEN(j)  (2304 + 64 * (j))
#define XB_TOP      3328
#define XB_TOPGEN   3392
#define XCD_BAR_WORDS 3456
#define XB_SPIN_CAP (1u << 18)

__device__ __forceinline__ unsigned xb_ld(unsigned* p)              { return __hip_atomic_load(p, __ATOMIC_RELAXED, __HIP_MEMORY_SCOPE_AGENT); }
__device__ __forceinline__ unsigned xb_add(unsigned* p, unsigned v) { return __hip_atomic_fetch_add(p, v, __ATOMIC_RELAXED, __HIP_MEMORY_SCOPE_AGENT); }
__device__ __forceinline__ unsigned xb_xcc_id() { return (unsigned)__builtin_amdgcn_s_getreg((3 << 11) | 20) & 0xFu; }
#define XB_SPIN(cond, bar) do { unsigned _sp = 0; while (cond) { __builtin_amdgcn_s_sleep(1); \
    if ((++_sp & 255u) == 0u) { if (xb_ld(&(bar)[XB_TMO])) break; if (_sp > XB_SPIN_CAP) { atomicAdd(&(bar)[XB_TMO], 1u); break; } } } } while (0)

struct XcdBarrier {
    unsigned* bar; unsigned x;
    volatile LAS unsigned* st;
};

__device__ __forceinline__ XcdBarrier xcd_barrier_post(unsigned* bar, volatile LAS unsigned* st) {
    XcdBarrier b; b.bar = bar; b.x = xb_xcc_id(); b.st = st;
    if (threadIdx.x == 0) (void)xb_add(&bar[XB_XCNT(b.x)], 1u);
    return b;
}
__device__ __forceinline__ void xcd_barrier_complete(unsigned* bar, unsigned x, unsigned& nloc, unsigned& nx) {
    const unsigned G = gridDim.x * gridDim.y * gridDim.z;
    unsigned sum, cnt, mine, sp = 0u;
    for (;;) {
        sum = 0u; cnt = 0u; mine = 0u;
#pragma unroll
        for (unsigned j = 0; j < 16; ++j) { const unsigned c = xb_ld(&bar[XB_XCNT(j)]); sum += c; cnt += (c > 0u) ? 1u : 0u; mine = (j == x) ? c : mine; }
        if (sum == G) break;
        __builtin_amdgcn_s_sleep(1);
        if ((++sp & 255u) == 0u) { if (xb_ld(&bar[XB_TMO])) break; if (sp > XB_SPIN_CAP) { atomicAdd(&bar[XB_TMO], 1u); break; } }
    }
    nloc = mine > 0u ? mine : 1u; nx = cnt > 0u ? cnt : 1u;
}

__device__ __forceinline__ void xcd_barrier(const XcdBarrier& b) {
    asm volatile("s_waitcnt vmcnt(0)" ::: "memory");
    __syncthreads();
    if (threadIdx.x == 0) {
        unsigned* bar = b.bar;
        __builtin_amdgcn_s_waitcnt(0);
        unsigned nloc = b.st[0], nx = b.st[1];
        if (nloc == 0u) { xcd_barrier_complete(bar, b.x, nloc, nx); b.st[0] = nloc; b.st[1] = nx; }
        const unsigned old = xb_add(&bar[XB_XSUB(b.x)], 1u);
        const unsigned gen = old / nloc;
        if (old + 1u == (gen + 1u) * nloc) {
            __builtin_amdgcn_fence(__ATOMIC_RELEASE, "agent");
            asm volatile("s_waitcnt vmcnt(0)" ::: "memory");
            const unsigned og = xb_add(&bar[XB_TOP], 1u);
            const unsigned tg = og / nx;
            if (og + 1u == (tg + 1u) * nx) xb_add(&bar[XB_TOPGEN], 1u);
            else XB_SPIN(xb_ld(&bar[XB_TOPGEN]) == tg, bar);
            __builtin_amdgcn_fence(__ATOMIC_ACQUIRE, "agent");
            xb_add(&bar[XB_XGEN(b.x)], 1u);
            asm volatile("s_waitcnt vmcnt(0)" ::: "memory");
        } else {
            XB_SPIN(xb_ld(&bar[XB_XGEN(b.x)]) == gen, bar);
            __builtin_amdgcn_fence(__ATOMIC_ACQUIRE, "agent");
            asm volatile("s_waitcnt vmcnt(0)" ::: "memory");
        }
    }
    __syncthreads();
}

template <class Sched> __device__ __forceinline__ void prep_rs(const Sched& S, LAS float* tab, const float* ssp, int nq, float invn, int tid) {
    for (int i = 0; i < 8; ++i) { pg8::Unit u; if (!S.next(i, u)) break;
        if (tid < 256) { const f32x4* pp = (const f32x4*)(ssp + (size_t)(u.pm * 256 + tid) * 32); float s = 0.f;
            for (int q = 0; q < nq; ++q) { const f32x4 v = pp[q]; s += (v[0] + v[1]) + (v[2] + v[3]); }
            tab[i * 256 + tid] = rsqrtf(s * invn + EPS); } }
    __syncthreads();
}
__global__ void __launch_bounds__(NTHR, 2) mega_fwd(Params P) {
    extern __shared__ __attribute__((aligned(16))) unsigned char lds_raw[];
    cg::grid_group grid = cg::this_grid();
    const int ph_lo = P.ph_lo, ph_hi = P.ph_hi;
    volatile LAS unsigned* misc = (volatile LAS unsigned*)((LAS unsigned char*)lds_raw + MISC_OFF);
#ifdef LDS_POISON
    for (int i_ = threadIdx.x; i_ < MISC_OFF / 4; i_ += NTHR) ((LAS unsigned*)lds_raw)[i_] = LDS_POISON;
#endif
    if (threadIdx.x < 64) misc[threadIdx.x] = 0u;
    __syncthreads();
    XcdBarrier xbar = xcd_barrier_post((unsigned*)(P.ws + WS_CTL), misc);
    if (ph_hi < 0) grid.sync();
    const int wave_s = __builtin_amdgcn_readfirstlane((int)threadIdx.x >> 6);
#define BUILD_FRAME() \
        const CAS Params* pp = (const CAS Params*)__builtin_amdgcn_kernarg_segment_ptr(); asm volatile("" : "+s"(pp)); \
        int tid_ = wave_s * 64 + (int)__builtin_amdgcn_mbcnt_hi(~0u, __builtin_amdgcn_mbcnt_lo(~0u, 0u)); asm volatile("" : "+v"(tid_)); \
        int bid_ = blockIdx.x; asm volatile("" : "+s"(bid_)); \
        int G_ = gridDim.x; asm volatile("" : "+s"(G_)); \
        Frame F; \
        F.lds = (LAS unsigned char*)lds_raw; F.tid = tid_; F.lane = tid_ & 63; F.wave = __builtin_amdgcn_readfirstlane(tid_ >> 6); F.G = G_; F.bid = bid_; \
        F.in = pp->in; F.out = pp->out; F.ws = pp->ws; \
        unsigned char* const ws = F.ws; \
        F.XF = (float*)(ws + WS_XF); F.XB = (bf16_t*)(ws + WS_XB); F.Z = (bf16_t*)(ws + WS_Z); F.CAT = (bf16_t*)(ws + WS_CAT); F.ZS = (bf16_t*)(ws + WS_ZS); F.H = (bf16_t*)(ws + WS_H); \
        F.SS = (float*)(ws + WS_SS); F.SPp = (float*)(ws + WS_SP); F.SC = (float*)(ws + WS_SC); F.SPo = (float*)(ws + WS_SPO);
    int ph = ph_lo;
#ifdef EXTRA_FIRST_BAR
    if (ph == 0) xcd_barrier(xbar);
#endif
#if defined(NAN_POISON) && (NAN_POISON & 64)
    if (ph == 0) { BUILD_FRAME(); const size_t t0_ = (size_t)F.bid * NTHR + F.tid, nt_ = (size_t)F.G * NTHR; const u32x4 nanv = (u32x4){0xffffffffu, 0xffffffffu, 0xffffffffu, 0xffffffffu};
        if (NAN_POISON & 128) for (size_t i = t0_; i < (WS_Z - WS_W) / 16; i += nt_) ((u32x4*)(F.ws + WS_W))[i] = nanv;
        if (NAN_POISON & 256) for (size_t i = t0_; i < ((size_t)MP * 32 * 4) / 16; i += nt_) ((u32x4*)(F.ws + WS_SS))[i] = nanv;
        for (size_t i = t0_; i < (WS_SC - WS_SP) / 16; i += nt_) ((u32x4*)(F.ws + WS_SP))[i] = nanv;
        for (size_t i = t0_; i < (WS_END - WS_SPO) / 16; i += nt_) ((u32x4*)(F.ws + WS_SPO))[i] = nanv;
        xcd_barrier(xbar); }
#endif
    if (ph == 0) { { BUILD_FRAME(); if (PHMASK & 128) phase_prologue(F); }
#if (REP_MASK >> 7) & 1
        __syncthreads(); { BUILD_FRAME(); phase_prologue(F); }
#endif
        ++ph; __syncthreads(); }
    int did_rep = 0;
    const int ph_end = ph_hi < N_PHASES - 1 ? ph_hi : N_PHASES - 1;
#pragma unroll 1
    for (; ph < ph_end; ++ph) {
        if (ph > ph_lo) xcd_barrier(xbar);
        BUILD_FRAME();
        const int l = (ph - 1) / 7, s = (ph - 1) % 7;
        const bf16_t* wl = (const bf16_t*)(ws + WS_W + (size_t)l * WL_SIZE);
        float* ssl = F.SS + (size_t)(4 * l) * MP * 32; constexpr size_t SSA = (size_t)MP * 32;
        LAS float* tab0 = (LAS float*)(F.lds + pg8::STAGE_BYTES); LAS float* tab1 = tab0 + 2048;
        if (s == 0) { if (PHMASK & 1) {
            pg8::Gemm g{F.XB, wl + WL_IN / 2, MP, DIN, DM}; pg8::StaticOrder S; S.init(MP, DIN, F.G, (int)F.bid);
            prep_rs(S, tab0, ssl, 8, 1.0f / 2048.0f, F.tid);
            pg8::EpiIn E{F.Z, DIN, tab0};
            pg8::gemm_phase<pg8::EpiIn, pg8::StaticOrder, true, true>(F.lds, g, S, E, F.tid);
            if (PRO_LAYERS < DEPTH && l + 1 >= PRO_LAYERS && l + 1 < DEPTH) { int n2 = S.nwg - F.G; if (n2 < 0 || n2 >= F.G) n2 = 0;
                if (F.bid >= n2) { __syncthreads(); convert_weights(F, l + 1, l + 2, (F.bid - n2) * NWAVES + F.wave, (F.G - n2) * NWAVES); } } }
        } else if (s == 1) {
            if (PHMASK & 2) phase_attention(F, l); __syncthreads(); if (PHMASK & 512) {
#ifdef SCAN_OLD_A
 phase_scan_a_old(F, l);
#else
 phase_scan_a(F, l);
#endif
 }
        } else if (s == 2) {
            {
#ifdef SCAN_OLD_C
 phase_scan_c_old(F, l);
#else
 phase_scan_c(F, l);
#endif
 }
        } else if (s == 3) { if (PHMASK & 8) {
            pg8::Gemm g{F.ZS, wl + WL_GLU / 2, MP, SW, SW}; pg8::StaticOrder S; S.init(MP, SW, F.G, (int)F.bid);
            pg8::EpiGlu E{F.ZS, SW, F.CAT + AW, DM, ssl + 2 * SSA};
            pg8::gemm_phase<pg8::EpiGlu, pg8::StaticOrder, true, true>(F.lds, g, S, E, F.tid);
 }
        } else if (s == 4) { if (PHMASK & 16) {
            pg8::Gemm g{F.CAT, wl + WL_OUT / 2, MPR, DM, DM}; pg8::StaticOrder S; S.init(MPR, DM, F.G, (int)F.bid);
            prep_rs(S, tab0, ssl + 1 * SSA, 4, 1.0f / 1024.0f, F.tid); prep_rs(S, tab1, ssl + 2 * SSA, 4, 1.0f / 1024.0f, F.tid);
            for (int i = F.tid; i < 2048; i += NTHR) tab0[i] = tab0[i] / tab1[i];
            __syncthreads();
            pg8::EpiRes<true> E{F.XF, F.XB, DM, ssl + 3 * SSA, tab0, tab1, AW / pg8::BK};
            pg8::gemm_phase<pg8::EpiRes<true>, pg8::StaticOrder, true, true>(F.lds, g, S, E, F.tid); __syncthreads();
            skinny_res(F, F.CAT, DM, wl + WL_OUT / 2, ssl + 3 * SSA, ssl + 1 * SSA, ssl + 2 * SSA, true); }
        } else if (s == 5) { if (PHMASK & 32) {
            pg8::Gemm g{F.XB, wl + WL_GU / 2, MP, 2 * DFF, DM}; pg8::StaticOrder S; S.init(MP, 2 * DFF, F.G, (int)F.bid);
            prep_rs(S, tab0, ssl + 3 * SSA, 8, 1.0f / 2048.0f, F.tid);
            pg8::EpiGU E{F.H, DFF, tab0};
            pg8::gemm_phase<pg8::EpiGU, pg8::StaticOrder, true, true>(F.lds, g, S, E, F.tid);
 }
        } else { if (PHMASK & 64) {
            pg8::Gemm g{F.H, wl + WL_DN / 2, MPR, DM, DFF}; pg8::StaticOrder S; S.init(MPR, DM, F.G, (int)F.bid);
            pg8::EpiRes<false> E{F.XF, F.XB, DM, ssl + 4 * SSA, (LAS float*)nullptr, (LAS float*)nullptr, -1};
            pg8::gemm_phase<pg8::EpiRes<false>, pg8::StaticOrder, true, true>(F.lds, g, S, E, F.tid); __syncthreads();
            skinny_res(F, F.H, DFF, wl + WL_DN / 2, ssl + 4 * SSA, nullptr, nullptr, false);
 }
        }
        __syncthreads();
        if (REP_MASK & 127) { if (((REP_MASK >> s) & 1) && !did_rep) { did_rep = 1; --ph; } else did_rep = 0; }
    }
#ifdef EXTRA_SYNCS
    for (int xs = 0; xs < EXTRA_SYNCS; ++xs) xcd_barrier(xbar);
#endif
    if (ph_hi == N_PHASES) { if (ph > ph_lo) xcd_barrier(xbar); BUILD_FRAME(); if (PHMASK & 256) phase_final(F); }
}

extern "C" void kernel_launch(void* const* d_in, const int* in_sizes, int n_in, void* d_out, int out_size, void* d_ws, size_t ws_size, hipStream_t stream) {
    static int grid = 0;
    if (grid == 0) {
        if (n_in != N_IN || (size_t)out_size != O_END || ws_size < WS_END) { fprintf(stderr, "kernel_launch: unexpected sizes: n_in %d out %d ws %zu (need %zu)\n", n_in, out_size, ws_size, (size_t)WS_END); grid = -1; return; }
        int dev = 0, cus = 0, per_cu = 0;
        (void)hipGetDevice(&dev); (void)hipDeviceGetAttribute(&cus, hipDeviceAttributeMultiprocessorCount, dev);
        if (hipFuncSetAttribute((const void*)mega_fwd, hipFuncAttributeMaxDynamicSharedMemorySize, LDS_BYTES) != hipSuccess) { fprintf(stderr, "kernel_launch: hipFuncSetAttribute failed\n"); grid = -1; return; }
        if (hipOccupancyMaxActiveBlocksPerMultiprocessor(&per_cu, (const void*)mega_fwd, NTHR, LDS_BYTES) != hipSuccess || per_cu < 1) { fprintf(stderr, "kernel_launch: occupancy query gave %d\n", per_cu); per_cu = 1; }
        (void)hipGetLastError();
        grid = cus * per_cu;
        fprintf(stderr, "kernel_launch: grid %d (cus %d x %d)\n", grid, cus, per_cu);
    }
    if (grid < 0) return;
    if (hipMemsetAsync((char*)d_ws + WS_CTL, 0, CTL_BYTES, stream) != hipSuccess) { fprintf(stderr, "kernel_launch: memset failed\n"); return; }
    Params p{};
    for (int i = 0; i < N_IN; ++i) p.in[i] = (const float*)d_in[i];
    p.out = (float*)d_out; p.ws = (unsigned char*)d_ws;
#if MK_SINGLE
    p.ph_lo = 0; p.ph_hi = N_PHASES;
    void* args[] = {&p};
    const hipError_t e = hipLaunchCooperativeKernel((const void*)mega_fwd, dim3(grid), dim3(NTHR), args, LDS_BYTES, stream);
    if (e != hipSuccess) fprintf(stderr, "kernel_launch: cooperative launch failed: %s (grid %d)\n", hipGetErrorString(e), grid);
#else
    for (int ph = 0; ph < N_PHASES; ++ph) { p.ph_lo = ph; p.ph_hi = ph + 1; hipLaunchKernelGGL(mega_fwd, dim3(grid), dim3(NTHR), LDS_BYTES, stream, p); }
#endif
}
```
